# Optimizing an MI355X kernel written in HIP

```python
import jax
import jax.numpy as jnp
from jax import lax
import numpy as np

D_MODEL = 1024
BATCH = 16
SEQ = 256
DEPTH = 2
DEC_BATCH = 2
DEC_SEQ = 1024
PAST_LEN = 256

GRID_W = 64
N_EVEN = (DEPTH + 1) // 2
N_ODD = DEPTH // 2
HEAD_DIM = 64
NA_WIDTH = D_MODEL // 2
NA_HEADS = NA_WIDTH // HEAD_DIM
WIN_H = 8
WIN_W = 16
LRU_WIDTH = D_MODEL // 2
LRU_BLOCKS = 8
LRU_BLOCK = LRU_WIDTH // LRU_BLOCKS
LRU_C = 8.0
CONV_W = 4
FOURIER_GROUPS = 4
D_FF = 2816
N_MOD = 9
IN_WIDTH = 3 * NA_WIDTH + 2 * LRU_WIDTH
CTX_Q_BLOCK = 128
EPS = 1e-6

kernel_name = 'hybrid_natten_rglru_fnet_diffusion_step'


def rms_norm(x, g):
    xf = x.astype(jnp.float32)
    y = xf * lax.rsqrt(jnp.mean(xf * xf, axis=-1, keepdims=True) + EPS)
    return (y * g.astype(jnp.float32)).astype(x.dtype)


def modulate(h, shift, scale):
    return h * (1 + scale[:, None, :]) + shift[:, None, :]


def swiglu(h, w_gate, w_up, w_down):
    return (jax.nn.silu(h @ w_gate) * (h @ w_up)) @ w_down


def depthwise_conv_centred(x, w, b):
    t = x.shape[1]
    left = (CONV_W - 1) // 2
    xp = jnp.pad(x, ((0, 0), (left, CONV_W - 1 - left), (0, 0)))
    out = b
    for j in range(CONV_W):
        out = out + xp[:, j:j + t] * w[j]
    return out


def block_diag_linear(x, w, b):
    bsz, t, _ = x.shape
    y = jnp.einsum('btni,nij->btnj', x.reshape(bsz, t, LRU_BLOCKS, LRU_BLOCK), w)
    return y.reshape(bsz, t, LRU_WIDTH) + b


def rglru_coeffs(xc, w_r, b_r, w_i, b_i, lam):
    r = jax.nn.sigmoid(block_diag_linear(xc, w_r, b_r).astype(jnp.float32))
    i = jax.nn.sigmoid(block_diag_linear(xc, w_i, b_i).astype(jnp.float32))
    log_a = LRU_C * r * jax.nn.log_sigmoid(lam.astype(jnp.float32))
    a = jnp.exp(log_a)
    u = jnp.sqrt(-jnp.expm1(2.0 * log_a)) * (i * xc.astype(jnp.float32))
    return a, u


def linear_scan(a, u, h0, reverse):
    def step(h, au):
        h = au[0] * h + au[1]
        return h, h
    h_last, hs = lax.scan(step, h0, (jnp.swapaxes(a, 0, 1), jnp.swapaxes(u, 0, 1)), reverse=reverse)
    return jnp.swapaxes(hs, 0, 1), h_last


def rglru_bidir(xb, gb, conv_w, conv_b, w_r, b_r, w_i, b_i, lam, h0_fwd, h0_bwd):
    xc = depthwise_conv_centred(xb, conv_w, conv_b)
    a_f, u_f = rglru_coeffs(xc, w_r[0], b_r[0], w_i[0], b_i[0], lam[0])
    a_b, u_b = rglru_coeffs(xc, w_r[1], b_r[1], w_i[1], b_i[1], lam[1])
    h_f, hl_f = linear_scan(a_f, u_f, h0_fwd.astype(jnp.float32), False)
    h_b, hl_b = linear_scan(a_b, u_b, h0_bwd.astype(jnp.float32), True)
    y = (h_f + h_b).astype(xb.dtype) * jax.nn.gelu(gb)
    return y, hl_f, hl_b


def context_attention(q, k, v):
    bsz, s, h, dh = q.shape
    nq = s // CTX_Q_BLOCK
    qb = jnp.moveaxis(q.reshape(bsz, nq, CTX_Q_BLOCK, h, dh), 1, 0)

    def one_block(qi):
        sc = jnp.einsum('bqhd,bkhd->bhqk', qi, k).astype(jnp.float32)
        p = jax.nn.softmax(sc, axis=-1).astype(v.dtype)
        return jnp.einsum('bhqk,bkhd->bqhd', p, v)

    o = lax.map(one_block, qb)
    return jnp.moveaxis(o, 0, 1).reshape(bsz, s, h, dh)


def neighbourhood_attention(q, k, v, k_ctx, v_ctx, rpb):
    bsz, t, h, dh = q.shape
    rows = t // GRID_W
    kh = min(WIN_H, rows)
    r = jnp.arange(rows)
    row_start = jnp.clip(r - kh // 2, 0, rows - kh)
    key_rows = row_start[:, None] + jnp.arange(kh)[None, :]
    cq = jnp.arange(GRID_W)
    col_start = jnp.clip(cq - WIN_W // 2, 0, GRID_W - WIN_W)
    col_in = (cq[None, :] >= col_start[:, None]) & (cq[None, :] < col_start[:, None] + WIN_W)
    dr_idx = key_rows - r[:, None] + (WIN_H - 1)
    dc_idx = jnp.clip(cq[None, :] - cq[:, None] + (WIN_W - 1), 0, 2 * WIN_W - 2)
    bias = rpb[:, dr_idx[:, None, :, None], dc_idx[None, :, None, :]].astype(jnp.float32)
    bias = jnp.where(col_in[None, None, :, None, :], bias, -jnp.inf)

    qg = q.reshape(bsz, rows, GRID_W, h, dh)
    kg = k.reshape(bsz, rows, GRID_W, h, dh)[:, key_rows]
    vg = v.reshape(bsz, rows, GRID_W, h, dh)[:, key_rows]
    s_loc = jnp.einsum('brqhd,brkchd->bhrqkc', qg, kg).astype(jnp.float32) + bias[None]
    s_ctx = jnp.einsum('brqhd,bphd->bhrqp', qg, k_ctx).astype(jnp.float32)
    n_loc = kh * GRID_W
    s_all = jnp.concatenate([s_loc.reshape(bsz, h, rows, GRID_W, n_loc), s_ctx], axis=-1)
    p = jax.nn.softmax(s_all, axis=-1).astype(v.dtype)
    p_loc = p[..., :n_loc].reshape(bsz, h, rows, GRID_W, kh, GRID_W)
    p_ctx = p[..., n_loc:]
    o = (jnp.einsum('bhrqkc,brkchd->brqhd', p_loc, vg)
         + jnp.einsum('bhrqp,bphd->brqhd', p_ctx, v_ctx))
    return o.reshape(bsz, t, h, dh)


def mix_ab(h, w_in, q_g, k_g, rpb, conv_w, conv_b, w_r, b_r, w_i, b_i, lam, w_out, past):
    bsz, t, _ = h.shape
    proj = h @ w_in
    q, k, v, xb, gb = jnp.split(
        proj, [NA_WIDTH, 2 * NA_WIDTH, 3 * NA_WIDTH, 3 * NA_WIDTH + LRU_WIDTH], axis=-1)
    q = rms_norm(q.reshape(bsz, t, NA_HEADS, HEAD_DIM), q_g) * (HEAD_DIM ** -0.5)
    k = rms_norm(k.reshape(bsz, t, NA_HEADS, HEAD_DIM), k_g)
    v = v.reshape(bsz, t, NA_HEADS, HEAD_DIM)
    if past is None:
        o = context_attention(q, k, v)
        zeros = jnp.zeros((bsz, LRU_WIDTH), jnp.float32)
        y_b, hl_f, hl_b = rglru_bidir(xb, gb, conv_w, conv_b, w_r, b_r, w_i, b_i, lam, zeros, zeros)
        new = (k, v, hl_f.astype(h.dtype), hl_b.astype(h.dtype))
    else:
        k_ctx, v_ctx, h0_f, h0_b = past
        o = neighbourhood_attention(q, k, v, k_ctx, v_ctx, rpb)
        y_b, _, _ = rglru_bidir(xb, gb, conv_w, conv_b, w_r, b_r, w_i, b_i, lam, h0_f, h0_b)
        new = None
    y = jnp.concatenate([o.reshape(bsz, t, NA_WIDTH), y_b], axis=-1) @ w_out
    return y, new


def fourier_mix(h, w_out):
    bsz, t, _ = h.shape
    hg = h.astype(jnp.float32).reshape(bsz, t, FOURIER_GROUPS, D_MODEL // FOURIER_GROUPS)
    f = jnp.fft.fft2(hg, axes=(1, 3), norm='ortho').real
    return f.reshape(bsz, t, D_MODEL).astype(h.dtype) @ w_out


def trunk(x, cond, prm, past):
    s_cond = jax.nn.silu(cond)
    new_k, new_v, new_hf, new_hb = [], [], [], []
    for l in range(DEPTH):
        mod = (s_cond @ prm['w_ada'][l] + prm['b_ada'][l]).reshape(-1, N_MOD, D_MODEL)
        g = prm['norm_g'][l]
        hh = modulate(rms_norm(x, g[0]), mod[:, 0], mod[:, 1])
        x = x + 0.5 * mod[:, 2][:, None, :] * swiglu(hh, prm['ffn1_gate'][l], prm['ffn1_up'][l], prm['ffn1_down'][l])
        hh = modulate(rms_norm(x, g[1]), mod[:, 3], mod[:, 4])
        if l % 2 == 0:
            e = l // 2
            layer_past = None if past is None else (past[0][:, e], past[1][:, e], past[2][:, e], past[3][:, e])
            y, new = mix_ab(hh, prm['w_in'][e], prm['q_norm_g'][e], prm['k_norm_g'][e], prm['rpb'][e],
                            prm['conv_w'][e], prm['conv_b'][e], prm['lru_w_r'][e], prm['lru_b_r'][e],
                            prm['lru_w_i'][e], prm['lru_b_i'][e], prm['lru_lambda'][e], prm['w_out_ab'][e],
                            layer_past)
            if new is not None:
                new_k.append(new[0])
                new_v.append(new[1])
                new_hf.append(new[2])
                new_hb.append(new[3])
        else:
            y = fourier_mix(hh, prm['w_out_c'][l // 2])
        x = x + mod[:, 5][:, None, :] * y
        hh = modulate(rms_norm(x, g[2]), mod[:, 6], mod[:, 7])
        x = x + 0.5 * mod[:, 8][:, None, :] * swiglu(hh, prm['ffn2_gate'][l], prm['ffn2_up'][l], prm['ffn2_down'][l])
    if past is None:
        states = (jnp.stack(new_k, axis=1), jnp.stack(new_v, axis=1),
                  jnp.stack(new_hf, axis=1), jnp.stack(new_hb, axis=1))
    else:
        states = None
    return x, states


def setup_inputs(seed: int = 0) -> dict:
    key = jax.random.key(seed)
    ks = jax.random.split(key, 32)

    def nrm(k, shape, s):
        return jax.random.normal(k, shape, jnp.float32) * s

    a0 = jax.random.uniform(ks[28], (N_EVEN, 2, LRU_WIDTH), jnp.float32, 0.9, 0.999)
    sig = a0 ** (1.0 / LRU_C)
    lru_lambda = jnp.log(sig) - jnp.log1p(-sig)
    return {
        'x_prompt': nrm(ks[0], (BATCH, SEQ, D_MODEL), 1.0),
        'x_sample': nrm(ks[1], (DEC_BATCH, DEC_SEQ, D_MODEL), 1.0),
        'cache_k': nrm(ks[2], (DEC_BATCH, N_EVEN, PAST_LEN, NA_HEADS, HEAD_DIM), 1.0),
        'cache_v': nrm(ks[3], (DEC_BATCH, N_EVEN, PAST_LEN, NA_HEADS, HEAD_DIM), 1.0),
        'state_lru_fwd': nrm(ks[4], (DEC_BATCH, N_EVEN, LRU_WIDTH), 0.5),
        'state_lru_bwd': nrm(ks[5], (DEC_BATCH, N_EVEN, LRU_WIDTH), 0.5),
        'c': nrm(ks[6], (DEC_BATCH, D_MODEL), 1.0),
        'c_ctx': nrm(ks[7], (D_MODEL,), 1.0),
        'w_ada': nrm(ks[8], (DEPTH, D_MODEL, N_MOD * D_MODEL), 0.5 * D_MODEL ** -0.5),
        'b_ada': nrm(ks[9], (DEPTH, N_MOD * D_MODEL), 0.01),
        'norm_g': 1.0 + nrm(ks[10], (DEPTH, 3, D_MODEL), 0.02),
        'ffn1_gate': nrm(ks[11], (DEPTH, D_MODEL, D_FF), D_MODEL ** -0.5),
        'ffn1_up': nrm(ks[12], (DEPTH, D_MODEL, D_FF), D_MODEL ** -0.5),
        'ffn1_down': nrm(ks[13], (DEPTH, D_FF, D_MODEL), D_FF ** -0.5),
        'ffn2_gate': nrm(ks[14], (DEPTH, D_MODEL, D_FF), D_MODEL ** -0.5),
        'ffn2_up': nrm(ks[15], (DEPTH, D_MODEL, D_FF), D_MODEL ** -0.5),
        'ffn2_down': nrm(ks[16], (DEPTH, D_FF, D_MODEL), D_FF ** -0.5),
        'w_in': nrm(ks[17], (N_EVEN, D_MODEL, IN_WIDTH), D_MODEL ** -0.5),
        'q_norm_g': 1.0 + nrm(ks[18], (N_EVEN, HEAD_DIM), 0.02),
        'k_norm_g': 1.0 + nrm(ks[19], (N_EVEN, HEAD_DIM), 0.02),
        'rpb': nrm(ks[20], (N_EVEN, NA_HEADS, 2 * WIN_H - 1, 2 * WIN_W - 1), 0.1),
        'conv_w': nrm(ks[21], (N_EVEN, CONV_W, LRU_WIDTH), CONV_W ** -0.5),
        'conv_b': nrm(ks[22], (N_EVEN, LRU_WIDTH), 0.01),
        'lru_w_r': nrm(ks[23], (N_EVEN, 2, LRU_BLOCKS, LRU_BLOCK, LRU_BLOCK), LRU_BLOCK ** -0.5),
        'lru_b_r': nrm(ks[24], (N_EVEN, 2, LRU_WIDTH), 0.01),
        'lru_w_i': nrm(ks[25], (N_EVEN, 2, LRU_BLOCKS, LRU_BLOCK, LRU_BLOCK), LRU_BLOCK ** -0.5),
        'lru_b_i': nrm(ks[26], (N_EVEN, 2, LRU_WIDTH), 0.01),
        'lru_lambda': lru_lambda,
        'w_out_ab': nrm(ks[29], (N_EVEN, NA_WIDTH + LRU_WIDTH, D_MODEL), (NA_WIDTH + LRU_WIDTH) ** -0.5),
        'w_out_c': nrm(ks[30], (N_ODD, D_MODEL, D_MODEL), D_MODEL ** -0.5),
    }


def reference(x_prompt, x_sample, cache_k, cache_v, state_lru_fwd, state_lru_bwd, c, c_ctx,
              w_ada, b_ada, norm_g, ffn1_gate, ffn1_up, ffn1_down, ffn2_gate, ffn2_up, ffn2_down,
              w_in, q_norm_g, k_norm_g, rpb, conv_w, conv_b, lru_w_r, lru_b_r, lru_w_i, lru_b_i,
              lru_lambda, w_out_ab, w_out_c):
    prm = {
        'w_ada': w_ada, 'b_ada': b_ada, 'norm_g': norm_g,
        'ffn1_gate': ffn1_gate, 'ffn1_up': ffn1_up, 'ffn1_down': ffn1_down,
        'ffn2_gate': ffn2_gate, 'ffn2_up': ffn2_up, 'ffn2_down': ffn2_down,
        'w_in': w_in, 'q_norm_g': q_norm_g, 'k_norm_g': k_norm_g, 'rpb': rpb,
        'conv_w': conv_w, 'conv_b': conv_b, 'lru_w_r': lru_w_r, 'lru_b_r': lru_b_r,
        'lru_w_i': lru_w_i, 'lru_b_i': lru_b_i, 'lru_lambda': lru_lambda,
        'w_out_ab': w_out_ab, 'w_out_c': w_out_c,
    }
    y_prompt, ctx_states = trunk(x_prompt, c_ctx[None, :], prm, None)
    new_cache_k, new_cache_v, new_state_lru_fwd, new_state_lru_bwd = ctx_states
    y_sample, _ = trunk(x_sample, c, prm, (cache_k, cache_v, state_lru_fwd, state_lru_bwd))
    return (y_prompt, y_sample, new_cache_k, new_cache_v, new_state_lru_fwd, new_state_lru_bwd)
```

```cpp
#include <hip/hip_runtime.h>
#include <hip/hip_cooperative_groups.h>
#include <cstdio>
namespace cg = cooperative_groups;

typedef unsigned short u16;
using bf16x8 = __attribute__((ext_vector_type(8))) short;
using bf16x4 = __attribute__((ext_vector_type(4))) short;
using f32x16 = __attribute__((ext_vector_type(16))) float;
using f32x4 = __attribute__((ext_vector_type(4))) float;

#ifndef ONE_LAUNCH
#define ONE_LAUNCH 1
#endif

constexpr int NTOK = 6144, NCTX = 4096, DM = 1024, DFF = 2816;
constexpr int NPH = 22;

constexpr size_t WS_MOD = 0;
constexpr size_t WS_WGU = WS_MOD + 221184;
constexpr size_t WS_WD = WS_WGU + 4ull * 5632 * 1024 * 2;
constexpr size_t WS_WIN = WS_WD + 4ull * 1024 * 2816 * 2;
constexpr size_t WS_WOAB = WS_WIN + 2560ull * 1024 * 2;
constexpr size_t WS_WOC = WS_WOAB + 1024ull * 1024 * 2;
constexpr size_t WS_CKB = WS_WOC + 1024ull * 1024 * 2;
constexpr size_t WS_CVT = WS_CKB + 524288;
constexpr size_t WS_LRUW = WS_CVT + 524288;
constexpr size_t WS_CT256 = WS_LRUW + 262144;
constexpr size_t WS_CT1024 = WS_CT256 + 262144;
constexpr size_t WS_CS2 = WS_CT1024 + 4194304;
constexpr size_t WS_X = WS_CS2 + 262144;
constexpr size_t WS_HN = WS_X + 6144ull * 1024 * 4;
constexpr size_t WS_H = WS_HN + 6144ull * 1024 * 2;
constexpr size_t WS_Q = WS_H + 6144ull * 2816 * 2;
constexpr size_t WS_K = WS_Q + 6144ull * 512 * 2;
constexpr size_t WS_VT = WS_K + 6144ull * 512 * 2;
constexpr size_t WS_XB = WS_VT + 6144ull * 512 * 2;
constexpr size_t WS_GG = WS_XB + 6144ull * 512 * 4;
constexpr size_t WS_MIX = WS_GG + 6144ull * 512 * 2;
constexpr size_t WS_Z = WS_MIX + 6144ull * 1024 * 2;
constexpr size_t WS_AGGA = WS_Z + 6144ull * 2048 * 2;
constexpr size_t WS_AGGH = WS_AGGA + 393216;
constexpr size_t WS_BAR = WS_AGGH + 393216;
constexpr size_t WS_HL = WS_BAR + 16384;
constexpr size_t WS_Z2 = WS_HL + 2ull * 6144 * 512 * 4;
constexpr size_t WS_F = WS_Z;
constexpr size_t WS_HNB = WS_Z2 + 6144ull * 2048 * 2;
constexpr size_t WS_END = WS_HNB + 6144ull * 1024 * 2;

constexpr int SMEM_BYTES = 81920 - 16;

struct Params {
  const float* in[30];
  float* out;
  char* ws;
  int ph_lo, ph_hi, coop, pad;
};

struct EpiP {
  float* outf; u16* outb; int ldc; int tok0;
  const float* res0; const float* res1;
  const float* gate; float gscale; int T;
  u16 *q, *k, *vT, *gg; float* xb;
  const float *qg, *kg; float *outk, *outv;
};

__device__ __forceinline__ u16 f2bf(float f) {
  unsigned u = __float_as_uint(f);
  u += 0x7fffu + ((u >> 16) & 1u);
  return (u16)(u >> 16);
}
__device__ __forceinline__ unsigned pack2(float a, float b) { return (unsigned)f2bf(a) | ((unsigned)f2bf(b) << 16); }
__device__ __forceinline__ float bf2f(u16 v) { return __uint_as_float(((unsigned)v) << 16); }
__device__ __forceinline__ float sigmoidf_(float x) { return 1.f / (1.f + __expf(-x)); }
__device__ __forceinline__ int cond_of(int row) { return row < NCTX ? 0 : 1 + ((row - NCTX) >> 10); }

__device__ __forceinline__ int TID() { int t = __builtin_amdgcn_workitem_id_x(); asm volatile("" : "+v"(t)); return t; }

__device__ __forceinline__ void st_wt(u16* p, u16 v) { __hip_atomic_store(p, v, __ATOMIC_RELAXED, __HIP_MEMORY_SCOPE_AGENT); }
__device__ __forceinline__ void st_wt(float* p, float v) { *p = v; }
__device__ __forceinline__ void st_wt(uint2* p, uint2 v) {
  unsigned long long w = (unsigned long long)v.x | ((unsigned long long)v.y << 32);
  __hip_atomic_store((unsigned long long*)p, w, __ATOMIC_RELAXED, __HIP_MEMORY_SCOPE_AGENT);
}

enum { EPI_SWIGLU = 0, EPI_RESID = 1, EPI_INPROJ = 2, EPI_DFTT = 3, EPI_BF16 = 4 };

template <int EPI, int WR = 2, int WC = 2, int MI = 2, int NI = 2>
__device__ __forceinline__ void gemm_tile(const u16* __restrict__ A, int lda, const u16* __restrict__ Bt, int ldb,
                                          int K, int m0, int n0, const EpiP& e, char* smem) {
  constexpr int TM = WR * MI * 32, TN = WC * NI * 32, NA = TM / 32, NB = TN / 32;
  static_assert(WR * WC == 4, "4 waves");
  static_assert(EPI == EPI_RESID || EPI == EPI_BF16 || (WR == 2 && WC == 2 && NI == 2 && (MI == 2 || EPI == EPI_SWIGLU)), "tile config not supported by this epilogue");
  typedef unsigned v4u __attribute__((ext_vector_type(4)));
  const int tid = TID(), lane = tid & 63, wid = tid >> 6, wr = wid / WC, wc = wid % WC;
  u16* sA = (u16*)smem;
  u16* sB = sA + 2 * TM * 72;
  f32x16 acc[MI][NI];
#pragma unroll
  for (int i = 0; i < MI; ++i)
#pragma unroll
    for (int j = 0; j < NI; ++j)
#pragma unroll
      for (int r = 0; r < 16; ++r) acc[i][j][r] = 0.f;
  typedef __attribute__((address_space(3))) void* lds_ptr_t;
  const int lr8 = lane >> 3, lp = lane & 7;
  const int nk = K >> 6;
  const u16* gA[NA]; const u16* gB[NB];
#pragma unroll
  for (int j = 0; j < NA; ++j) { const int r = 8 * (j * 4 + wid) + lr8; gA[j] = A + (size_t)(m0 + r) * lda + ((lp ^ ((r >> 1) & 7)) << 3); }
#pragma unroll
  for (int j = 0; j < NB; ++j) { const int r = 8 * (j * 4 + wid) + lr8; gB[j] = Bt + (size_t)(n0 + r) * ldb + ((lp ^ ((r >> 1) & 7)) << 3); }
  char* const sAl = smem + wid * 1024 + lane * 16;
  char* const sBl = smem + 2 * TM * 128 + wid * 1024 + lane * 16;
#define G_ISSUE(BUF, KO) { \
    _Pragma("unroll") for (int j = 0; j < NA; ++j) __builtin_amdgcn_global_load_lds((const void*)(gA[j] + (KO)), (lds_ptr_t)(sAl + (BUF) * TM * 128 + j * 4096), 16, 0, 0); \
    _Pragma("unroll") for (int j = 0; j < NB; ++j) __builtin_amdgcn_global_load_lds((const void*)(gB[j] + (KO)), (lds_ptr_t)(sBl + (BUF) * TN * 128 + j * 4096), 16, 0, 0); }
  const int fsw = ((lane & 31) >> 1) & 7;
#define G_COMPUTE(BUF) { \
    const char* a_base = smem + (BUF) * TM * 128 + (wr * MI * 32 + (lane & 31)) * 128; \
    const char* b_base = smem + 2 * TM * 128 + (BUF) * TN * 128 + (wc * NI * 32 + (lane & 31)) * 128; \
    _Pragma("unroll") for (int ks = 0; ks < 4; ++ks) { \
      const int co = ((ks * 2 + (lane >> 5)) ^ fsw) << 4; \
      bf16x8 af[MI], bfr[NI]; \
      _Pragma("unroll") for (int mi = 0; mi < MI; ++mi) af[mi] = *(const bf16x8*)(a_base + mi * 32 * 128 + co); \
      _Pragma("unroll") for (int ni = 0; ni < NI; ++ni) bfr[ni] = *(const bf16x8*)(b_base + ni * 32 * 128 + co); \
      _Pragma("unroll") for (int mi = 0; mi < MI; ++mi) \
        _Pragma("unroll") for (int ni = 0; ni < NI; ++ni) \
          acc[mi][ni] = __builtin_amdgcn_mfma_f32_32x32x16_bf16(af[mi], bfr[ni], acc[mi][ni], 0, 0, 0); } }
  G_ISSUE(0, 0)
  asm volatile("s_waitcnt vmcnt(0)" ::: "memory");
  __syncthreads();
  for (int kt = 0; kt < nk; kt += 2) {
    G_ISSUE(1, (kt + 1) * 64)
    G_COMPUTE(0)
    asm volatile("s_waitcnt vmcnt(0)" ::: "memory");
    __syncthreads();
    if (kt + 2 < nk) { G_ISSUE(0, (kt + 2) * 64) }
    G_COMPUTE(1)
    asm volatile("s_waitcnt vmcnt(0)" ::: "memory");
    __syncthreads();
  }
#undef G_ISSUE
#undef G_COMPUTE
  const int l31 = lane & 31, lh = lane >> 5;
  if constexpr (EPI == EPI_SWIGLU) {
    const int colh = (n0 >> 1) + wc * 32 + l31;
#pragma unroll
    for (int mi = 0; mi < MI; ++mi)
#pragma unroll
      for (int r = 0; r < 16; ++r) {
        const int row = m0 + wr * (MI * 32) + mi * 32 + (r & 3) + 8 * (r >> 2) + 4 * lh;
        const float g = acc[mi][0][r], u = acc[mi][1][r];
        e.outb[(size_t)row * DFF + colh] = f2bf(g * sigmoidf_(g) * u);
      }
  } else if constexpr (EPI == EPI_RESID) {
    const float* res1m = e.res1 - (size_t)NCTX * DM;
    float g3[NI][3];
#pragma unroll
    for (int ni = 0; ni < NI; ++ni)
#pragma unroll
      for (int c = 0; c < 3; ++c) g3[ni][c] = e.gscale * e.gate[c * 9216 + n0 + wc * (NI * 32) + ni * 32 + l31];
    float rv[MI][NI][16];
#pragma unroll
    for (int mi = 0; mi < MI; ++mi)
#pragma unroll
      for (int r = 0; r < 16; ++r) {
        const int row = m0 + wr * (MI * 32) + mi * 32 + (r & 3) + 8 * (r >> 2) + 4 * lh;
        const float* rp = (row < NCTX ? e.res0 : res1m) + (size_t)row * DM;
#pragma unroll
        for (int ni = 0; ni < NI; ++ni) rv[mi][ni][r] = rp[n0 + wc * (NI * 32) + ni * 32 + l31];
      }
    asm volatile("" ::: "memory"); __builtin_amdgcn_sched_barrier(0);
#pragma unroll
    for (int mi = 0; mi < MI; ++mi)
#pragma unroll
      for (int r = 0; r < 16; ++r) {
        const int row = m0 + wr * (MI * 32) + mi * 32 + (r & 3) + 8 * (r >> 2) + 4 * lh;
        const int c = cond_of(row);
#pragma unroll
        for (int ni = 0; ni < NI; ++ni) {
          const int col = n0 + wc * (NI * 32) + ni * 32 + l31;
          const float gg_ = c == 0 ? g3[ni][0] : (c == 1 ? g3[ni][1] : g3[ni][2]);
          st_wt(&e.outf[(size_t)row * DM + col], rv[mi][ni][r] + gg_ * acc[mi][ni][r]);
        }
      }
  } else if constexpr (EPI == EPI_INPROJ) {
    const int sec = n0 >> 9;
    const int cb = (n0 & 511) + wc * 64;
    if (sec <= 1) {
      const float* gv = sec == 0 ? e.qg : e.kg;
      const float g0 = gv[l31], g1 = gv[32 + l31];
      const float sc = sec == 0 ? 0.125f : 1.f;
#pragma unroll
      for (int mi = 0; mi < 2; ++mi)
#pragma unroll
        for (int r = 0; r < 16; ++r) {
          const int row = m0 + wr * 64 + mi * 32 + (r & 3) + 8 * (r >> 2) + 4 * lh;
          const float v0 = acc[mi][0][r], v1 = acc[mi][1][r];
          float ss = v0 * v0 + v1 * v1;
          ss += __shfl_xor(ss, 1); ss += __shfl_xor(ss, 2); ss += __shfl_xor(ss, 4);
          ss += __shfl_xor(ss, 8); ss += __shfl_xor(ss, 16);
          const float rs = rsqrtf(ss * (1.f / 64.f) + 1e-6f) * sc;
          const float o0 = v0 * rs * g0, o1 = v1 * rs * g1;
          u16* dst = (sec == 0 ? e.q : e.k) + (size_t)row * 512 + cb;
          dst[l31] = f2bf(o0); dst[32 + l31] = f2bf(o1);
          if (sec == 1 && row < NCTX) {
            __builtin_nontemporal_store(o0, &e.outk[(size_t)row * 512 + cb + l31]);
            __builtin_nontemporal_store(o1, &e.outk[(size_t)row * 512 + cb + 32 + l31]);
          }
        }
    } else if (sec == 2) {
#pragma unroll
      for (int mi = 0; mi < 2; ++mi)
#pragma unroll
        for (int ni = 0; ni < 2; ++ni) {
          const int col = cb + ni * 32 + l31;
#pragma unroll
          for (int q4 = 0; q4 < 4; ++q4) {
            const int row = m0 + wr * 64 + mi * 32 + 8 * q4 + 4 * lh;
            uint2 pk;
            pk.x = pack2(acc[mi][ni][4 * q4 + 0], acc[mi][ni][4 * q4 + 1]);
            pk.y = pack2(acc[mi][ni][4 * q4 + 2], acc[mi][ni][4 * q4 + 3]);
            *(uint2*)(e.vT + (size_t)col * NTOK + row) = pk;
            if (row < NCTX) {
#pragma unroll
              for (int j = 0; j < 4; ++j) __builtin_nontemporal_store(acc[mi][ni][4 * q4 + j], &e.outv[(size_t)(row + j) * 512 + col]);
            }
          }
        }
    } else {
#pragma unroll
      for (int mi = 0; mi < 2; ++mi)
#pragma unroll
        for (int r = 0; r < 16; ++r) {
          const int row = m0 + wr * 64 + mi * 32 + (r & 3) + 8 * (r >> 2) + 4 * lh;
#pragma unroll
          for (int ni = 0; ni < 2; ++ni) {
            const int col = cb + ni * 32 + l31;
            const float v = acc[mi][ni][r];
            if (sec == 3) __builtin_nontemporal_store(v, &e.xb[(size_t)row * 512 + col]);
            else {
              const float t = tanhf(0.7978845608028654f * (v + 0.044715f * v * v * v));
              e.gg[(size_t)row * 512 + col] = f2bf(0.5f * v * (1.f + t));
            }
          }
        }
    }
  } else if constexpr (EPI == EPI_DFTT) {
#pragma unroll
    for (int mi = 0; mi < 2; ++mi)
#pragma unroll
      for (int r = 0; r < 16; ++r) {
        const int m = m0 + wr * 64 + mi * 32 + (r & 3) + 8 * (r >> 2) + 4 * lh;
        const int cs = m >= e.T ? 1 : 0;
        const int kt = m - cs * e.T;
#pragma unroll
        for (int ni = 0; ni < 2; ++ni) {
          const int d = n0 + wc * 64 + ni * 32 + l31;
          e.outb[(size_t)(e.tok0 + kt) * 2048 + (d >> 8) * 512 + cs * 256 + (d & 255)] = f2bf(acc[mi][ni][r]);
        }
      }
  } else {
#pragma unroll
    for (int mi = 0; mi < MI; ++mi)
#pragma unroll
      for (int r = 0; r < 16; ++r) {
        const int row = m0 + wr * (MI * 32) + mi * 32 + (r & 3) + 8 * (r >> 2) + 4 * lh;
#pragma unroll
        for (int ni = 0; ni < NI; ++ni) {
          const int col = n0 + wc * (NI * 32) + ni * 32 + l31;
          e.outb[(size_t)row * e.ldc + col] = f2bf(acc[mi][ni][r]);
        }
      }
  }
}

__device__ __forceinline__ void tc_tile(const float* __restrict__ src, int lds_, u16* __restrict__ dst, int ldd,
                                        int k0, int n0, int mode, float* sT) {
  const int tid = TID();
  const int r = tid >> 4, c4 = (tid & 15) * 4;
#pragma unroll
  for (int p = 0; p < 4; ++p) {
    const float4 v = *(const float4*)(src + (size_t)(k0 + r + 16 * p) * lds_ + n0 + c4);
    float* d = sT + (r + 16 * p) * 65 + c4;
    d[0] = v.x; d[1] = v.y; d[2] = v.z; d[3] = v.w;
  }
  __syncthreads();
  const int n = tid >> 2, kq = (tid & 3) * 16;
  unsigned w[8];
#pragma unroll
  for (int j = 0; j < 8; ++j) w[j] = pack2(sT[(kq + 2 * j) * 65 + n], sT[(kq + 2 * j + 1) * 65 + n]);
  const int gn = n0 + n;
  const int drow = mode == 0 ? gn : ((gn >> 5) * 64 + (mode - 1) * 32 + (gn & 31));
  uint4* dp = (uint4*)(dst + (size_t)drow * ldd + k0 + kq);
  dp[0] = make_uint4(w[0], w[1], w[2], w[3]);
  dp[1] = make_uint4(w[4], w[5], w[6], w[7]);
  __syncthreads();
}

__device__ __forceinline__ void mod_item(int item, const Params& p, char* smem) {
  const int l = item / 144, cb = item % 144;
  const int tid = TID();
  float* sS = (float*)smem;
  float* sR = sS + 3072;
  {
    float cv[12];
#pragma unroll
    for (int q = 0; q < 12; ++q) {
      const int i = tid + 256 * q, ci = i >> 10, k = i & 1023;
      const float* src = ci == 0 ? p.in[7] : p.in[6] + (ci - 1) * 1024;
      cv[q] = src[k];
    }
    asm volatile("" ::: "memory"); __builtin_amdgcn_sched_barrier(0);
#pragma unroll
    for (int q = 0; q < 12; ++q) sS[tid + 256 * q] = cv[q] * sigmoidf_(cv[q]);
  }
  __syncthreads();
  const int c4 = (tid & 15) * 4, ks = tid >> 4;
  float acc[3][4];
#pragma unroll
  for (int a = 0; a < 3; ++a)
#pragma unroll
    for (int b = 0; b < 4; ++b) acc[a][b] = 0.f;
  const float* wp = p.in[8] + ((size_t)l * 1024 + ks * 64) * 9216 + cb * 64 + c4;
  typedef float v4f __attribute__((ext_vector_type(4)));
  for (int kk0 = 0; kk0 < 64; kk0 += 16) {
    v4f w[16];
#pragma unroll
    for (int i = 0; i < 16; ++i) w[i] = __builtin_nontemporal_load((const v4f*)(wp + (size_t)(kk0 + i) * 9216));
    asm volatile("" ::: "memory"); __builtin_amdgcn_sched_barrier(0);
#pragma unroll
    for (int i = 0; i < 16; ++i) {
      const int k = ks * 64 + kk0 + i;
#pragma unroll
      for (int ci = 0; ci < 3; ++ci) {
        const float s = sS[ci * 1024 + k];
        acc[ci][0] += s * w[i].x; acc[ci][1] += s * w[i].y; acc[ci][2] += s * w[i].z; acc[ci][3] += s * w[i].w;
      }
    }
  }
#pragma unroll
  for (int ci = 0; ci < 3; ++ci)
#pragma unroll
    for (int b = 0; b < 4; ++b) sR[(ks * 3 + ci) * 64 + c4 + b] = acc[ci][b];
  __syncthreads();
  if (tid < 192) {
    const int ci = tid >> 6, cc = tid & 63;
    float s = p.in[9][l * 9216 + cb * 64 + cc];
#pragma unroll
    for (int k2 = 0; k2 < 16; ++k2) s += sR[(k2 * 3 + ci) * 64 + cc];
    ((float*)(p.ws + WS_MOD))[(l * 3 + ci) * 9216 + cb * 64 + cc] = s;
  }
  __syncthreads();
}

struct TcJob { const float* src; u16* dst; int lds_, ldd, k0, n0, mode; };
__device__ __forceinline__ TcJob tc_decode(int t, const Params& p) {
  TcJob j;
  if (t < 2816) {
    const int m = t / 704, rem = t % 704, isup = rem / 352, tt = rem % 352;
    const int l = m >> 1, f = m & 1;
    j.src = p.in[f == 0 ? (isup ? 12 : 11) : (isup ? 15 : 14)] + (size_t)l * 1024 * DFF; j.lds_ = DFF;
    j.dst = (u16*)(p.ws + WS_WGU) + (size_t)m * 5632 * 1024; j.ldd = 1024;
    j.k0 = (tt / 22) * 64; j.n0 = (tt % 22) * 128; j.mode = 1 + isup;
    return j;
  }
  t -= 2816;
  if (t < 1408) {
    const int m = t / 352, tt = t % 352;
    const int l = m >> 1, f = m & 1;
    j.src = p.in[f == 0 ? 13 : 16] + (size_t)l * DFF * 1024; j.lds_ = 1024;
    j.dst = (u16*)(p.ws + WS_WD) + (size_t)m * 1024 * DFF; j.ldd = DFF;
    j.k0 = (tt / 8) * 64; j.n0 = (tt % 8) * 128; j.mode = 0;
    return j;
  }
  t -= 1408;
  if (t < 320) { j.src = p.in[17]; j.lds_ = 2560; j.dst = (u16*)(p.ws + WS_WIN); j.ldd = 1024; j.k0 = (t / 20) * 64; j.n0 = (t % 20) * 128; j.mode = 0; return j; }
  t -= 320;
  if (t < 128) { j.src = p.in[28]; j.lds_ = 1024; j.dst = (u16*)(p.ws + WS_WOAB); j.ldd = 1024; j.k0 = (t / 8) * 64; j.n0 = (t % 8) * 128; j.mode = 0; return j; }
  t -= 128;
  if (t < 128) { j.src = p.in[29]; j.lds_ = 1024; j.dst = (u16*)(p.ws + WS_WOC); j.ldd = 1024; j.k0 = (t / 8) * 64; j.n0 = (t % 8) * 128; j.mode = 0; return j; }
  t -= 128;
  {
    const int b = t / 16, r = t % 16;
    j.src = p.in[3] + (size_t)b * 256 * 512; j.lds_ = 512; j.dst = (u16*)(p.ws + WS_CVT) + (size_t)b * 512 * 256; j.ldd = 256;
    j.k0 = (r / 4) * 64; j.n0 = (r % 4) * 128; j.mode = 0;
    return j;
  }
}
constexpr int N_TC = 2816 + 1408 + 320 + 128 + 128 + 32;

struct TcPlan { int s[4]; int n[4]; };
__device__ __forceinline__ int tc_map(const TcPlan& pl, int v) {
#pragma unroll
  for (int i = 0; i < 4; ++i) { if (v < pl.n[i]) return pl.s[i] + v; v -= pl.n[i]; }
  return -1;
}
__device__ __forceinline__ void tc_run(const Params& p, char* smem, const TcPlan& pl, int rank, int nranks) {
  float* sT = (float*)smem;
  const int total = pl.n[0] + pl.n[1] + pl.n[2] + pl.n[3];
  const int tid = TID();
  const int lr = tid >> 5, lc4 = (tid & 31) * 4;
  typedef float v4f_nt __attribute__((ext_vector_type(4)));
  v4f_nt v[8];
  TcJob cur{}, nxt{};
  int t = rank;
  bool have = t < total;
  if (have) {
    cur = tc_decode(tc_map(pl, t), p);
#pragma unroll
    for (int q = 0; q < 8; ++q) v[q] = __builtin_nontemporal_load((const v4f_nt*)(cur.src + (size_t)(cur.k0 + lr + 8 * q) * cur.lds_ + cur.n0 + lc4));
  }
  while (have) {
#pragma unroll
    for (int q = 0; q < 8; ++q) {
      float* d = sT + (lr + 8 * q) * 129 + lc4;
      d[0] = v[q].x; d[1] = v[q].y; d[2] = v[q].z; d[3] = v[q].w;
    }
    __syncthreads();
    const int tn = t + nranks;
    const bool haven = tn < total;
    if (haven) {
      nxt = tc_decode(tc_map(pl, tn), p);
#pragma unroll
      for (int q = 0; q < 8; ++q) v[q] = __builtin_nontemporal_load((const v4f_nt*)(nxt.src + (size_t)(nxt.k0 + lr + 8 * q) * nxt.lds_ + nxt.n0 + lc4));
    }
    {
      const int n = tid & 127, kq = (tid >> 7) * 32;
      unsigned w[16];
#pragma unroll
      for (int j = 0; j < 16; ++j) w[j] = pack2(sT[(kq + 2 * j) * 129 + n], sT[(kq + 2 * j + 1) * 129 + n]);
      const int gn = cur.n0 + n;
      const int drow = cur.mode == 0 ? gn : ((gn >> 5) * 64 + (cur.mode - 1) * 32 + (gn & 31));
      uint4* dp = (uint4*)(cur.dst + (size_t)drow * cur.ldd + cur.k0 + kq);
      dp[0] = make_uint4(w[0], w[1], w[2], w[3]);
      dp[1] = make_uint4(w[4], w[5], w[6], w[7]);
      dp[2] = make_uint4(w[8], w[9], w[10], w[11]);
      dp[3] = make_uint4(w[12], w[13], w[14], w[15]);
    }
    __syncthreads();
    cur = nxt; t = tn; have = haven;
  }
}

__device__ void phase_prep(const Params& p, char* smem) {
  float* sT = (float*)smem;
  const int b = blockIdx.x, nb = gridDim.x;
  for (int t = b; t < 288; t += nb) mod_item(t, p, smem);
  for (int t = b; t < 32; t += nb) {
    const int dir = t / 16, blk = (t / 2) % 8, gate = t % 2;
    tc_tile(p.in[gate ? 25 : 23] + (size_t)(dir * 8 + blk) * 4096, 64,
            (u16*)(p.ws + WS_LRUW) + (size_t)((dir * 8 + blk) * 2 + gate) * 4096, 64, 0, 0, 0, sT);
  }
  {
    const TcPlan pl{{0, 4800, 0, 0}, {704, 32, 0, 0}};
    if (nb > 352) { if (b >= 288) tc_run(p, smem, pl, b - 288, nb - 288); }
    else tc_run(p, smem, pl, b, nb);
  }
  const int gt = blockIdx.x * 256 + TID(), gs = gridDim.x * 256;
  u16* ct256 = (u16*)(p.ws + WS_CT256);
  for (int i = gt; i < 512 * 256; i += gs) {
    const int m = i >> 8, t = i & 255, cs = m >> 8, kt = m & 255;
    const float ang = 2.f * (float)((kt * t) & 255) * (1.f / 256.f);
    ct256[i] = f2bf((cs ? sinpif(ang) : cospif(ang)) * 0.0625f);
  }
  u16* ct1024 = (u16*)(p.ws + WS_CT1024);
  for (int i = gt; i < 2048 * 1024; i += gs) {
    const int m = i >> 10, t = i & 1023, cs = m >> 10, kt = m & 1023;
    const float ang = 2.f * (float)((kt * t) & 1023) * (1.f / 1024.f);
    ct1024[i] = f2bf((cs ? sinpif(ang) : cospif(ang)) * 0.03125f);
  }
  u16* cs2 = (u16*)(p.ws + WS_CS2);
  for (int i = gt; i < 256 * 512; i += gs) {
    const int kc = i >> 9, r = i & 511, cs = r >> 8, c = r & 255;
    const float ang = 2.f * (float)((kc * c) & 255) * (1.f / 256.f);
    cs2[i] = f2bf((cs ? -sinpif(ang) : cospif(ang)) * 0.0625f);
  }
  u16* ckb = (u16*)(p.ws + WS_CKB);
  for (int i = gt; i < 2 * 256 * 512; i += gs) ckb[i] = f2bf(p.in[2][i]);
}

__device__ __forceinline__ const float* xrow(const float* x0, const float* x1, int row) {
  return (row < NCTX ? x0 : x1 - (size_t)NCTX * DM) + (size_t)row * DM;
}

__device__ void phase_norm(const Params& p, const float* x0, const float* x1, int l, int which) {
  const int lane = TID() & 63, wid = TID() >> 6;
  const float* g = p.in[10] + (l * 3 + which) * 1024;
  const float* mod = (const float*)(p.ws + WS_MOD) + (size_t)l * 3 * 9216 + which * 3 * 1024;
  u16* hn = (u16*)(p.ws + (((l * 3 + which) & 1) ? WS_HNB : WS_HN));
  const int nw = gridDim.x * 4;
  float4 gv[4];
#pragma unroll
  for (int j = 0; j < 4; ++j) gv[j] = *(const float4*)(g + j * 256 + lane * 4);
  for (int base = blockIdx.x * 4 + wid; base < NTOK; base += 3 * nw) {
    float4 v[3][4], sh[3][4], sc[3][4];
#pragma unroll
    for (int j3 = 0; j3 < 3; ++j3) {
      int row = base + j3 * nw; row = row < NTOK ? row : NTOK - 1;
      const float* xr = xrow(x0, x1, row);
      const float* mp = mod + cond_of(row) * 9216;
#pragma unroll
      for (int j = 0; j < 4; ++j) {
        v[j3][j] = *(const float4*)(xr + j * 256 + lane * 4);
        sh[j3][j] = *(const float4*)(mp + j * 256 + lane * 4);
        sc[j3][j] = *(const float4*)(mp + 1024 + j * 256 + lane * 4);
      }
    }
    asm volatile("" : "+v"(v[1][0].x), "+v"(v[1][1].x), "+v"(v[1][2].x), "+v"(v[1][3].x), "+v"(v[2][0].x), "+v"(v[2][1].x), "+v"(v[2][2].x), "+v"(v[2][3].x),
                      "+v"(sh[1][0].x), "+v"(sh[1][1].x), "+v"(sh[1][2].x), "+v"(sh[1][3].x), "+v"(sh[2][0].x), "+v"(sh[2][1].x), "+v"(sh[2][2].x), "+v"(sh[2][3].x),
                      "+v"(sc[1][0].x), "+v"(sc[1][1].x), "+v"(sc[1][2].x), "+v"(sc[1][3].x), "+v"(sc[2][0].x), "+v"(sc[2][1].x), "+v"(sc[2][2].x), "+v"(sc[2][3].x));
#pragma unroll
    for (int j3 = 0; j3 < 3; ++j3) {
      const int row = base + j3 * nw;
      float ss = 0.f;
#pragma unroll
      for (int j = 0; j < 4; ++j) ss += v[j3][j].x * v[j3][j].x + v[j3][j].y * v[j3][j].y + v[j3][j].z * v[j3][j].z + v[j3][j].w * v[j3][j].w;
#pragma unroll
      for (int o = 1; o < 64; o <<= 1) ss += __shfl_xor(ss, o);
      const float rs = rsqrtf(ss * (1.f / 1024.f) + 1e-6f);
      if (row < NTOK) {
#pragma unroll
        for (int j = 0; j < 4; ++j) {
          const int c = j * 256 + lane * 4;
          uint2 pk;
          pk.x = pack2(v[j3][j].x * rs * gv[j].x * (1.f + sc[j3][j].x) + sh[j3][j].x, v[j3][j].y * rs * gv[j].y * (1.f + sc[j3][j].y) + sh[j3][j].y);
          pk.y = pack2(v[j3][j].z * rs * gv[j].z * (1.f + sc[j3][j].z) + sh[j3][j].z, v[j3][j].w * rs * gv[j].w * (1.f + sc[j3][j].w) + sh[j3][j].w);
          st_wt((uint2*)(hn + (size_t)row * DM + c), pk);
        }
      }
    }
  }
}

__device__ void phase_normT(const Params& p, const float* x0, const float* x1, int l, int which, char* smem) {
  const int tid = TID(), lane = tid & 63, wid = tid >> 6;
  const float* g = p.in[10] + (l * 3 + which) * 1024;
  const float* mod = (const float*)(p.ws + WS_MOD) + (size_t)l * 3 * 9216 + which * 3 * 1024;
  u16* hnT = (u16*)(p.ws + (((l * 3 + which) & 1) ? WS_HNB : WS_HN));
  u16* sT = (u16*)smem;
  float4 gv[4];
#pragma unroll
  for (int j = 0; j < 4; ++j) gv[j] = *(const float4*)(g + j * 256 + lane * 4);
  for (int item = blockIdx.x; item < NTOK / 32; item += gridDim.x) {
    const int tokb = item * 32;
    for (int rr0 = wid; rr0 < 32; rr0 += 8) {
      float4 v[2][4], sh[2][4], sc[2][4];
#pragma unroll
      for (int q = 0; q < 2; ++q) {
        const int row = tokb + rr0 + 4 * q;
        const float* xr = xrow(x0, x1, row);
        const float* mp = mod + cond_of(row) * 9216;
#pragma unroll
        for (int j = 0; j < 4; ++j) {
          v[q][j] = *(const float4*)(xr + j * 256 + lane * 4);
          sh[q][j] = *(const float4*)(mp + j * 256 + lane * 4);
          sc[q][j] = *(const float4*)(mp + 1024 + j * 256 + lane * 4);
        }
      }
      asm volatile("" : "+v"(v[0][0].x), "+v"(v[0][1].x), "+v"(v[0][2].x), "+v"(v[0][3].x), "+v"(v[1][0].x), "+v"(v[1][1].x), "+v"(v[1][2].x), "+v"(v[1][3].x),
                        "+v"(sh[0][0].x), "+v"(sh[0][1].x), "+v"(sh[0][2].x), "+v"(sh[0][3].x), "+v"(sh[1][0].x), "+v"(sh[1][1].x), "+v"(sh[1][2].x), "+v"(sh[1][3].x),
                        "+v"(sc[0][0].x), "+v"(sc[0][1].x), "+v"(sc[0][2].x), "+v"(sc[0][3].x), "+v"(sc[1][0].x), "+v"(sc[1][1].x), "+v"(sc[1][2].x), "+v"(sc[1][3].x));
#pragma unroll
      for (int q = 0; q < 2; ++q) {
        const int rr = rr0 + 4 * q;
        float ss = 0.f;
#pragma unroll
        for (int j = 0; j < 4; ++j) ss += v[q][j].x * v[q][j].x + v[q][j].y * v[q][j].y + v[q][j].z * v[q][j].z + v[q][j].w * v[q][j].w;
#pragma unroll
        for (int o = 1; o < 64; o <<= 1) ss += __shfl_xor(ss, o);
        const float rs = rsqrtf(ss * (1.f / 1024.f) + 1e-6f);
#pragma unroll
        for (int j = 0; j < 4; ++j) {
          const int c = j * 256 + lane * 4;
          u16* d = sT + rr * 1026 + c;
          d[0] = f2bf(v[q][j].x * rs * gv[j].x * (1.f + sc[q][j].x) + sh[q][j].x);
          d[1] = f2bf(v[q][j].y * rs * gv[j].y * (1.f + sc[q][j].y) + sh[q][j].y);
          d[2] = f2bf(v[q][j].z * rs * gv[j].z * (1.f + sc[q][j].z) + sh[q][j].z);
          d[3] = f2bf(v[q][j].w * rs * gv[j].w * (1.f + sc[q][j].w) + sh[q][j].w);
        }
      }
    }
    __syncthreads();
    int base, T, t0;
    if (tokb < NCTX) { base = (tokb >> 8) << 8; T = 256; t0 = tokb & 255; }
    else { base = NCTX + (((tokb - NCTX) >> 10) << 10); T = 1024; t0 = (tokb - NCTX) & 1023; }
#pragma unroll 4
    for (int it = 0; it < 16; ++it) {
      const int u = tid + 256 * it;
      const int d = u & 1023, tq = u >> 10;
      unsigned w[4];
#pragma unroll
      for (int j = 0; j < 4; ++j)
        w[j] = (unsigned)sT[(tq * 8 + 2 * j) * 1026 + d] | ((unsigned)sT[(tq * 8 + 2 * j + 1) * 1026 + d] << 16);
      *(uint4*)(hnT + (size_t)base * 1024 + (size_t)d * T + t0 + tq * 8) = make_uint4(w[0], w[1], w[2], w[3]);
    }
    __syncthreads();
  }
}

__device__ __forceinline__ void attn_item(int item, const Params& p, char* smem) {
  const int tid = TID(), lane = tid & 63, w = tid >> 6, l15 = lane & 15, g = lane >> 4;
  u16* sQ = (u16*)smem;
  u16* sK = sQ + 64 * 72;
  u16* sV = sK + 64 * 72;
  float* sRpb = (float*)(sQ + 5 * 64 * 72);
  const u16* QB = (const u16*)(p.ws + WS_Q);
  const u16* KB = (const u16*)(p.ws + WS_K);
  const u16* VT = (const u16*)(p.ws + WS_VT);
  const u16* CKB = (const u16*)(p.ws + WS_CKB);
  const u16* CVT = (const u16*)(p.ws + WS_CVT);
  u16* MIX = (u16*)(p.ws + WS_MIX);
  bool sample; int b, h, r = 0, rs = 0, tokq0, tok0, ntiles;
  if (item < 256) { sample = true; b = item >> 7; h = (item >> 4) & 7; r = item & 15; tok0 = NCTX + b * 1024; tokq0 = tok0 + r * 64; ntiles = 12;
    rs = r - 4; rs = rs < 0 ? 0 : (rs > 8 ? 8 : rs); }
  else { const int it = item - 256; sample = false; b = it >> 5; h = (it >> 2) & 7; tok0 = b * 256; tokq0 = tok0 + (it & 3) * 64; ntiles = 4; }
  const int lrow = tid >> 3, lseg = tid & 7;
#pragma unroll
  for (int i = 0; i < 2; ++i)
    *(uint4*)(sQ + (lrow + 32 * i) * 72 + lseg * 8) = *(const uint4*)(QB + (size_t)(tokq0 + lrow + 32 * i) * 512 + h * 64 + lseg * 8);
  if (sample) for (int i = tid; i < 465; i += 256) sRpb[i] = p.in[20][h * 465 + i];
  const int qc = 16 * w + l15;
  int cs = qc - 8; cs = cs < 0 ? 0 : (cs > 48 ? 48 : cs);
  float m_run = -1e30f, l_run = 0.f;
  f32x4 o[4];
#pragma unroll
  for (int mt = 0; mt < 4; ++mt) o[mt] = f32x4{0.f, 0.f, 0.f, 0.f};
  typedef unsigned v4u __attribute__((ext_vector_type(4)));
#define ATT_PTRS(TILE, KP, VP, VS) { \
    if (sample && (TILE) < 4) { KP = CKB + (size_t)(b * 256 + 64 * (TILE)) * 512 + h * 64; VP = CVT + (size_t)(b * 512 + h * 64) * 256 + 64 * (TILE); VS = 256; } \
    else if (sample) { const int kr_ = rs + (TILE) - 4; KP = KB + (size_t)(tok0 + kr_ * 64) * 512 + h * 64; VP = VT + (size_t)(h * 64) * NTOK + tok0 + kr_ * 64; VS = NTOK; } \
    else { KP = KB + (size_t)(tok0 + 64 * (TILE)) * 512 + h * 64; VP = VT + (size_t)(h * 64) * NTOK + tok0 + 64 * (TILE); VS = NTOK; } }
  v4u rk0, rk1, rv0, rv1;
  {
    const u16 *kptr, *vptr; int vstride;
    ATT_PTRS(0, kptr, vptr, vstride)
    rk0 = *(const v4u*)(kptr + (size_t)lrow * 512 + lseg * 8);
    rk1 = *(const v4u*)(kptr + (size_t)(lrow + 32) * 512 + lseg * 8);
    rv0 = *(const v4u*)(vptr + (size_t)lrow * vstride + lseg * 8);
    rv1 = *(const v4u*)(vptr + (size_t)(lrow + 32) * vstride + lseg * 8);
  }
  *(v4u*)(sK + lrow * 72 + lseg * 8) = rk0; *(v4u*)(sK + (lrow + 32) * 72 + lseg * 8) = rk1;
  *(v4u*)(sV + lrow * 72 + lseg * 8) = rv0; *(v4u*)(sV + (lrow + 32) * 72 + lseg * 8) = rv1;
  __syncthreads();
  bf16x8 bq[2];
#pragma unroll
  for (int ks = 0; ks < 2; ++ks) bq[ks] = *(const bf16x8*)(sQ + (16 * w + l15) * 72 + 32 * ks + 8 * g);
  for (int tile = 0; tile < ntiles; ++tile) {
    const int cur = tile & 1;
    const u16* cK = sK + cur * (2 * 64 * 72);
    const u16* cV = sV + cur * (2 * 64 * 72);
    const bool local = sample && tile >= 4;
    const int dr = local ? (rs + tile - 4) - r + 7 : 0;
    {
      const int tn = tile + 1 < ntiles ? tile + 1 : tile;
      const u16 *kptr, *vptr; int vstride;
      ATT_PTRS(tn, kptr, vptr, vstride)
      rk0 = *(const v4u*)(kptr + (size_t)lrow * 512 + lseg * 8);
      rk1 = *(const v4u*)(kptr + (size_t)(lrow + 32) * 512 + lseg * 8);
      rv0 = *(const v4u*)(vptr + (size_t)lrow * vstride + lseg * 8);
      rv1 = *(const v4u*)(vptr + (size_t)(lrow + 32) * vstride + lseg * 8);
    }
    f32x4 s[4];
#pragma unroll
    for (int nt = 0; nt < 4; ++nt) {
      s[nt] = f32x4{0.f, 0.f, 0.f, 0.f};
#pragma unroll
      for (int ks = 0; ks < 2; ++ks) {
        const bf16x8 a = *(const bf16x8*)(cK + (16 * nt + l15) * 72 + 32 * ks + 8 * g);
        s[nt] = __builtin_amdgcn_mfma_f32_16x16x32_bf16(a, bq[ks], s[nt], 0, 0, 0);
      }
    }
    if (local) {
#pragma unroll
      for (int nt = 0; nt < 4; ++nt)
#pragma unroll
        for (int i = 0; i < 4; ++i) {
          const int kc = 16 * nt + 4 * g + i;
          const bool valid = kc >= cs && kc < cs + 16;
          int bi = kc - qc + 15; bi = bi < 0 ? 0 : (bi > 30 ? 30 : bi);
          s[nt][i] = valid ? s[nt][i] + sRpb[dr * 31 + bi] : -1e30f;
        }
    }
    float tmax = -1e30f;
#pragma unroll
    for (int nt = 0; nt < 4; ++nt)
#pragma unroll
      for (int i = 0; i < 4; ++i) tmax = fmaxf(tmax, s[nt][i]);
    tmax = fmaxf(tmax, __shfl_xor(tmax, 16));
    tmax = fmaxf(tmax, __shfl_xor(tmax, 32));
    const float m_new = fmaxf(m_run, tmax);
    const float alpha = __expf(m_run - m_new);
    m_run = m_new;
    float ps = 0.f;
#pragma unroll
    for (int nt = 0; nt < 4; ++nt)
#pragma unroll
      for (int i = 0; i < 4; ++i) { s[nt][i] = __expf(s[nt][i] - m_new); ps += s[nt][i]; }
    l_run = l_run * alpha + ps;
#pragma unroll
    for (int mt = 0; mt < 4; ++mt)
#pragma unroll
      for (int i = 0; i < 4; ++i) o[mt][i] *= alpha;
#pragma unroll
    for (int s2 = 0; s2 < 2; ++s2) {
      union { bf16x8 v; unsigned u[4]; } bp;
      bp.u[0] = pack2(s[2 * s2][0], s[2 * s2][1]);
      bp.u[1] = pack2(s[2 * s2][2], s[2 * s2][3]);
      bp.u[2] = pack2(s[2 * s2 + 1][0], s[2 * s2 + 1][1]);
      bp.u[3] = pack2(s[2 * s2 + 1][2], s[2 * s2 + 1][3]);
#pragma unroll
      for (int mt = 0; mt < 4; ++mt) {
        union { bf16x8 v; uint2 u[2]; } av;
        av.u[0] = *(const uint2*)(cV + (16 * mt + l15) * 72 + 32 * s2 + 4 * g);
        av.u[1] = *(const uint2*)(cV + (16 * mt + l15) * 72 + 32 * s2 + 16 + 4 * g);
        o[mt] = __builtin_amdgcn_mfma_f32_16x16x32_bf16(av.v, bp.v, o[mt], 0, 0, 0);
      }
    }
    {
      u16* nK = sK + (cur ^ 1) * (2 * 64 * 72);
      u16* nV = sV + (cur ^ 1) * (2 * 64 * 72);
      *(v4u*)(nK + lrow * 72 + lseg * 8) = rk0; *(v4u*)(nK + (lrow + 32) * 72 + lseg * 8) = rk1;
      *(v4u*)(nV + lrow * 72 + lseg * 8) = rv0; *(v4u*)(nV + (lrow + 32) * 72 + lseg * 8) = rv1;
    }
    __syncthreads();
  }
#undef ATT_PTRS
  l_run += __shfl_xor(l_run, 16);
  l_run += __shfl_xor(l_run, 32);
  const float inv = 1.f / l_run;
#pragma unroll
  for (int mt = 0; mt < 4; ++mt) {
    uint2 pk;
    pk.x = pack2(o[mt][0] * inv, o[mt][1] * inv);
    pk.y = pack2(o[mt][2] * inv, o[mt][3] * inv);
    *(uint2*)(MIX + (size_t)(tokq0 + qc) * DM + h * 64 + 16 * mt + 4 * g) = pk;
  }
}

__device__ __forceinline__ void lru1_item(int item, const Params& p, char* smem) {
  const int tid = TID(), lane = tid & 63, wid = tid >> 6;
  const int ch = item >> 3, blk = item & 7;
  u16* sXc = (u16*)smem;
  float* sXf = (float*)(smem + 9216);
  u16* sW = (u16*)(smem + 9216 + 16384);
  float* sA = (float*)(smem + 9216 + 16384 + 18432);
  float* sU = sA + 4096;
  float* sSegA = sU + 4096;
  float* sSegH = sSegA + 256;
  const float* XB = (const float*)(p.ws + WS_XB);
  float* HL = (float*)(p.ws + WS_HL);
  float* AC = (float*)(p.ws + WS_Z);
  float* AGA = (float*)(p.ws + WS_AGGA);
  float* AGH = (float*)(p.ws + WS_AGGH);
  const int tokc = ch * 64;
  int T, t0;
  if (ch < 64) { T = 256; t0 = (ch & 3) * 64; } else { T = 1024; t0 = ((ch - 64) & 15) * 64; }
  const int seq0 = tokc - t0;
  {
    const int c = tid & 63, tq = tid >> 6, cg_ = blk * 64 + c;
    float xv[19];
#pragma unroll
    for (int i = 0; i < 19; ++i) {
      const int t = t0 + tq * 16 + i - 1;
      xv[i] = (t >= 0 && t < T) ? __builtin_nontemporal_load(&XB[(size_t)(seq0 + t) * 512 + cg_]) : 0.f;
    }
    const float w0 = p.in[21][cg_], w1 = p.in[21][512 + cg_], w2 = p.in[21][1024 + cg_], w3 = p.in[21][1536 + cg_];
    const float cb = p.in[22][cg_];
#pragma unroll
    for (int i = 0; i < 16; ++i) {
      const float xc = cb + w0 * xv[i] + w1 * xv[i + 1] + w2 * xv[i + 2] + w3 * xv[i + 3];
      sXf[(tq * 16 + i) * 64 + c] = xc;
      sXc[(tq * 16 + i) * 72 + c] = f2bf(xc);
    }
  }
  const int wr = wid >> 1, wc = wid & 1, l31 = lane & 31, lh = lane >> 5;
  typedef unsigned v4u_t __attribute__((ext_vector_type(4)));
  v4u_t wreg[2][4];
#pragma unroll
  for (int d = 0; d < 2; ++d) {
    const u16* wsrc = (const u16*)(p.ws + WS_LRUW) + (size_t)((d * 8 + blk) * 2) * 4096;
#pragma unroll
    for (int i = 0; i < 4; ++i) {
      const int idx = tid + 256 * i;
      wreg[d][i] = *(const v4u_t*)(wsrc + (idx >> 3) * 64 + (idx & 7) * 8);
    }
  }
  float pbr[2], pbi[2], plam[2];
  {
    const int cg2 = blk * 64 + 32 * wc + l31;
#pragma unroll
    for (int d = 0; d < 2; ++d) { pbr[d] = p.in[24][d * 512 + cg2]; pbi[d] = p.in[26][d * 512 + cg2]; plam[d] = p.in[27][d * 512 + cg2]; }
  }
#pragma unroll
  for (int dir = 0; dir < 2; ++dir) {
    {
#pragma unroll
      for (int i = 0; i < 4; ++i) {
        const int idx = tid + 256 * i;
        const int row = idx >> 3, seg = idx & 7;
        *(v4u_t*)(sW + row * 72 + seg * 8) = wreg[dir][i];
      }
    }
    __syncthreads();
    f32x16 aR, aI;
#pragma unroll
    for (int r = 0; r < 16; ++r) { aR[r] = 0.f; aI[r] = 0.f; }
#pragma unroll
    for (int ks = 0; ks < 4; ++ks) {
      const bf16x8 a = *(const bf16x8*)(sXc + (32 * wr + l31) * 72 + 16 * ks + 8 * lh);
      const bf16x8 br = *(const bf16x8*)(sW + (32 * wc + l31) * 72 + 16 * ks + 8 * lh);
      const bf16x8 bi = *(const bf16x8*)(sW + (64 + 32 * wc + l31) * 72 + 16 * ks + 8 * lh);
      aR = __builtin_amdgcn_mfma_f32_32x32x16_bf16(a, br, aR, 0, 0, 0);
      aI = __builtin_amdgcn_mfma_f32_32x32x16_bf16(a, bi, aI, 0, 0, 0);
    }
    {
      const int c = 32 * wc + l31, cg_ = blk * 64 + c;
      const float br_ = pbr[dir], bi_ = pbi[dir];
      const float lam = plam[dir];
      const float ls = -log1pf(expf(-lam));
#pragma unroll
      for (int r = 0; r < 16; ++r) {
        const int t = 32 * wr + (r & 3) + 8 * (r >> 2) + 4 * lh;
        const float rg = 1.f / (1.f + __expf(-(aR[r] + br_)));
        const float ig = 1.f / (1.f + __expf(-(aI[r] + bi_)));
        const float la = 8.f * rg * ls;
        float em = la * (1.f + la * (0.5f + la * (0.16666667f + la * (0.041666668f + la * (0.0083333338f + la * 0.0013888889f)))));
        if (la < -0.3f) em = expm1f(la);
        const float a = 1.f + em;
        const float u = sqrtf(-em * (2.f + em)) * (ig * sXf[t * 64 + c]);
        sA[t * 64 + c] = a;
        sU[t * 64 + c] = u;
      }
    }
    __syncthreads();
    {
      const int c = tid & 63, seg = tid >> 6, cg_ = blk * 64 + c;
      float hh = 0.f, AA = 1.f;
#pragma unroll
      for (int i = 0; i < 16; ++i) {
        const int n = seg * 16 + i;
        const int t = dir ? 63 - n : n;
        const float a = sA[t * 64 + c], u = sU[t * 64 + c];
        hh = a * hh + u; AA *= a;
        sU[t * 64 + c] = hh; sA[t * 64 + c] = AA;
      }
      sSegA[seg * 64 + c] = AA; sSegH[seg * 64 + c] = hh;
      __syncthreads();
      float cin = 0.f, P = 1.f;
#pragma unroll
      for (int s2 = 0; s2 < 3; ++s2) {
        if (s2 < seg) { const float a = sSegA[s2 * 64 + c]; cin = a * cin + sSegH[s2 * 64 + c]; P *= a; }
      }
      float hl_last = 0.f;
#pragma unroll
      for (int i = 0; i < 16; ++i) {
        const int n = seg * 16 + i;
        const int t = dir ? 63 - n : n;
        const float acs = sA[t * 64 + c];
        const float hl = sU[t * 64 + c] + acs * cin;
        const size_t gi = ((size_t)dir * NTOK + tokc + t) * 512 + cg_;
        __builtin_nontemporal_store(hl, &HL[gi]); __builtin_nontemporal_store(acs * P, &AC[gi]);
        hl_last = hl;
      }
      if (seg == 3) {
        AGA[(dir * 96 + ch) * 512 + cg_] = sSegA[3 * 64 + c] * P;
        AGH[(dir * 96 + ch) * 512 + cg_] = hl_last;
      }
    }
    __syncthreads();
  }
}

__device__ __forceinline__ void lru2_item(int item, const Params& p) {
  const int tid = TID();
  const int ch = item >> 4, qd = (item >> 2) & 3, tq = item & 3;
  const int c = qd * 128 + (tid & 127), th = tid >> 7;
  const float* HL = (const float*)(p.ws + WS_HL);
  const float* AC = (const float*)(p.ws + WS_Z);
  const float* AGA = (const float*)(p.ws + WS_AGGA);
  const float* AGH = (const float*)(p.ws + WS_AGGH);
  const u16* GG = (const u16*)(p.ws + WS_GG);
  u16* MIX = (u16*)(p.ws + WS_MIX);
  int first, nch; float cf, cb;
  if (ch < 64) { first = ch & ~3; nch = 4; cf = 0.f; cb = 0.f; }
  else { const int b = (ch - 64) >> 4; first = 64 + b * 16; nch = 16; cf = p.in[4][b * 512 + c]; cb = p.in[5][b * 512 + c]; }
  const int last = first + nch - 1;
  const int tokc = ch * 64, tb = tq * 16 + th * 8;
  float hl0[8], ac0[8], hl1[8], ac1[8], gg[8];
#pragma unroll
  for (int i = 0; i < 8; ++i) {
    const size_t g0 = ((size_t)tokc + tb + i) * 512 + c;
    const size_t g1 = g0 + (size_t)NTOK * 512;
    hl0[i] = __builtin_nontemporal_load(&HL[g0]); ac0[i] = __builtin_nontemporal_load(&AC[g0]);
    hl1[i] = __builtin_nontemporal_load(&HL[g1]); ac1[i] = __builtin_nontemporal_load(&AC[g1]); gg[i] = bf2f(GG[g0]);
  }
#pragma unroll
  for (int j = 0; j < 16; ++j) {
    int idx = first + j; const bool valid = idx < ch; idx = valid ? idx : first;
    const float a = AGA[(0 * 96 + idx) * 512 + c], hh = AGH[(0 * 96 + idx) * 512 + c];
    cf = valid ? a * cf + hh : cf;
  }
#pragma unroll
  for (int j = 0; j < 16; ++j) {
    int idx = last - j; const bool valid = idx > ch; idx = valid ? idx : last;
    const float a = AGA[(1 * 96 + idx) * 512 + c], hh = AGH[(1 * 96 + idx) * 512 + c];
    cb = valid ? a * cb + hh : cb;
  }
#pragma unroll
  for (int i = 0; i < 8; ++i) {
    const int t = tb + i;
    const float hf = hl0[i] + ac0[i] * cf;
    const float hb = hl1[i] + ac1[i] * cb;
    MIX[((size_t)tokc + t) * DM + 512 + c] = f2bf((hf + hb) * gg[i]);
    if (ch < 64) {
      if (t == 63 && (ch & 3) == 3) p.out[10485760 + (ch >> 2) * 512 + c] = hf;
      if (t == 0 && (ch & 3) == 0) p.out[10493952 + (ch >> 2) * 512 + c] = hb;
    }
  }
}

#define XB_TMO      128
#define XB_XCNT(j)  (256  + 64 * (j))
#define XB_XSUB(j)  (1280 + 64 * (j))
#define XB_XGEN(j)  (2304 + 64 * (j))
#define XB_TOP      3328
#define XB_TOPGEN   3392
#define XCD_BAR_WORDS 3456
#define XB_SPIN_CAP (1u << 18)
#define LAS __attribute__((address_space(3)))
__device__ __forceinline__ unsigned xb_ld(unsigned* p) { return __hip_atomic_load(p, __ATOMIC_RELAXED, __HIP_MEMORY_SCOPE_AGENT); }
__device__ __forceinline__ unsigned xb_add(unsigned* p, unsigned v) { return __hip_atomic_fetch_add(p, v, __ATOMIC_RELAXED, __HIP_MEMORY_SCOPE_AGENT); }
__device__ __forceinline__ unsigned xb_xcc_id() { return (unsigned)__builtin_amdgcn_s_getreg((3 << 11) | 20) & 0xFu; }
#define XB_SPIN(cond, bar) do { unsigned _sp = 0; while (cond) { __builtin_amdgcn_s_sleep(1); \
    if ((++_sp & 255u) == 0u) { if (xb_ld(&(bar)[XB_TMO])) break; if (_sp > XB_SPIN_CAP) { atomicAdd(&(bar)[XB_TMO], 1u); break; } } } } while (0)
struct XcdBarrier { unsigned* bar; unsigned x; volatile LAS unsigned* st; unsigned nloc, nx; };
__device__ __forceinline__ XcdBarrier xcd_barrier_post(unsigned* bar, volatile LAS unsigned* st) {
  XcdBarrier b; b.bar = bar; b.x = xb_xcc_id(); b.st = st; b.nloc = 0u; b.nx = 0u;
  if (threadIdx.x == 0) (void)xb_add(&bar[XB_XCNT(b.x)], 1u);
  return b;
}
__device__ __forceinline__ void xcd_barrier_complete(unsigned* bar, unsigned x, unsigned& nloc, unsigned& nx) {
  const unsigned G = gridDim.x * gridDim.y * gridDim.z;
  unsigned sum, cnt, mine, sp = 0u;
  for (;;) {
    sum = 0u; cnt = 0u; mine = 0u;
    unsigned cv[16];
#pragma unroll
    for (unsigned j = 0; j < 16; ++j) cv[j] = xb_ld(&bar[XB_XCNT(j)]);
    asm volatile("" ::: "memory"); __builtin_amdgcn_sched_barrier(0);
#pragma unroll
    for (unsigned j = 0; j < 16; ++j) { const unsigned c = cv[j]; sum += c; cnt += (c > 0u) ? 1u : 0u; mine = (j == x) ? c : mine; }
    if (sum == G) break;
    __builtin_amdgcn_s_sleep(1);
    if ((++sp & 255u) == 0u) { if (xb_ld(&bar[XB_TMO])) break; if (sp > XB_SPIN_CAP) { atomicAdd(&bar[XB_TMO], 1u); break; } }
  }
  nloc = mine > 0u ? mine : 1u; nx = cnt > 0u ? cnt : 1u;
}
__device__ __forceinline__ void xcd_barrier(XcdBarrier& b, bool acquire) {
  asm volatile("s_waitcnt vmcnt(0)" ::: "memory");
  __syncthreads();
  if (threadIdx.x == 0) {
    unsigned* bar = b.bar;
    __builtin_amdgcn_s_waitcnt(0);
    unsigned nloc = b.nloc, nx = b.nx;
    if (nloc == 0u) { xcd_barrier_complete(bar, b.x, nloc, nx); b.st[0] = nloc; b.st[1] = nx; }
    const unsigned old = xb_add(&bar[XB_XSUB(b.x)], 1u);
    const unsigned gen = old / nloc;
    if (old + 1u == (gen + 1u) * nloc) {
      __builtin_amdgcn_fence(__ATOMIC_RELEASE, "agent");
      asm volatile("s_waitcnt vmcnt(0)" ::: "memory");
      const unsigned og = xb_add(&bar[XB_TOP], 1u);
      const unsigned tg = og / nx;
      if (og + 1u == (tg + 1u) * nx) xb_add(&bar[XB_TOPGEN], 1u);
      else XB_SPIN(xb_ld(&bar[XB_TOPGEN]) == tg, bar);
      if (acquire) __builtin_amdgcn_fence(__ATOMIC_ACQUIRE, "agent");
      xb_add(&bar[XB_XGEN(b.x)], 1u);
      asm volatile("s_waitcnt vmcnt(0)" ::: "memory");
    } else {
      XB_SPIN(xb_ld(&bar[XB_XGEN(b.x)]) == gen, bar);
      if (acquire) __builtin_amdgcn_fence(__ATOMIC_ACQUIRE, "agent");
      asm volatile("s_waitcnt vmcnt(0)" ::: "memory");
    }
  }
  __syncthreads();
  if (b.nloc == 0u) { b.nloc = b.st[0]; b.nx = b.st[1]; }
}

enum { K_PREP, K_NORM0, K_GU1, K_DOWN1, K_NORM1, K_INPROJ, K_ATTLRU, K_LRU2, K_OUTAB, K_NORM2, K_GU2, K_DOWN2, K_NORMT, K_DFTT, K_DFTC, K_OUTC };
#define PHASE_FN __device__ __forceinline__

PHASE_FN void ph_prep(const Params& p, char* smem) { phase_prep(p, smem); }

PHASE_FN void ph_norm(const Params& p, int l, int kind, char* smem) {
  float* X = (float*)(p.ws + WS_X);
  const bool first = (l == 0 && kind == K_NORM0);
  const float* x0 = first ? p.in[0] : X;
  const float* x1 = first ? p.in[1] : X + (size_t)NCTX * DM;
  if (kind == K_NORMT) phase_normT(p, x0, x1, l, 1, smem);
  else phase_norm(p, x0, x1, l, kind == K_NORM0 ? 0 : kind == K_NORM1 ? 1 : 2);
}

PHASE_FN void ph_gu(const Params& p, int l, int f, char* smem) {
  EpiP e{}; e.outb = (u16*)(p.ws + (f ? WS_HL : WS_H));
  const u16* A = (const u16*)(p.ws + (((l * 3 + (f ? 2 : 0)) & 1) ? WS_HNB : WS_HN));
  const u16* Bt = (const u16*)(p.ws + WS_WGU) + (size_t)(l * 2 + f) * 5632 * 1024;
  for (int t = blockIdx.x; t < 32 * 44; t += gridDim.x)
    gemm_tile<EPI_SWIGLU, 2, 2, 3, 2>(A, 1024, Bt, 1024, 1024, (t % 32) * 192, (t / 32) * 128, e, smem);
  {
    const int nb = gridDim.x, extra = (32 * 44) % nb, b = blockIdx.x;
    TcPlan pl{{0, 0, 0, 0}, {0, 0, 0, 0}};
    if (l == 0 && f == 0) pl = TcPlan{{2816, 4224, 1088, 0}, {352, 320, 320, 0}};
    else if (l == 0 && f == 1) pl = TcPlan{{3168, 1408, 0, 0}, {352, 704, 0, 0}};
    else if (l == 1 && f == 0) pl = TcPlan{{3520, 4672, 2112, 0}, {352, 128, 704, 0}};
    else pl = TcPlan{{3872, 0, 0, 0}, {352, 0, 0, 0}};
    if (b >= extra) tc_run(p, smem, pl, b - extra, nb - extra);
  }
}

PHASE_FN void ph_resid(const Params& p, int l, int kind, int rep, char* smem) {
  float* X = (float*)(p.ws + WS_X);
  const bool first = (l == 0 && kind == K_DOWN1);
  const float* MOD = (const float*)(p.ws + WS_MOD) + (size_t)l * 3 * 9216;
  EpiP e{};
  const u16 *A, *Bt; int K, gi;
  if (kind == K_DOWN1 || kind == K_DOWN2) {
    const int f = kind == K_DOWN1 ? 0 : 1;
    A = (const u16*)(p.ws + (f ? WS_HL : WS_H)); K = DFF; Bt = (const u16*)(p.ws + WS_WD) + (size_t)(l * 2 + f) * 1024 * DFF;
    gi = f == 0 ? 2 : 8; e.gscale = 0.5f;
  } else if (kind == K_OUTAB) {
    A = (const u16*)(p.ws + WS_MIX); K = 1024; Bt = (const u16*)(p.ws + WS_WOAB); gi = 5; e.gscale = 1.f;
  } else {
    A = (const u16*)(p.ws + WS_F); K = 1024; Bt = (const u16*)(p.ws + WS_WOC); gi = 5; e.gscale = 1.f;
  }
  e.gate = MOD + gi * 1024;
  e.res0 = first ? p.in[0] : X;
  e.res1 = first ? p.in[1] : X + (size_t)NCTX * DM;
  e.outf = (l == 1 && kind == K_DOWN2) ? p.out : X;
  if (rep > 0) e.outf = (float*)(p.ws + WS_Z);
  for (int t = blockIdx.x; t < 64 * 8; t += gridDim.x)
    gemm_tile<EPI_RESID, 1, 4, 3, 1>(A, K, Bt, K, K, (t % 64) * 96, (t / 64) * 128, e, smem);
}

PHASE_FN void ph_inproj(const Params& p, char* smem) {
  EpiP e{};
  e.q = (u16*)(p.ws + WS_Q); e.k = (u16*)(p.ws + WS_K); e.vT = (u16*)(p.ws + WS_VT); e.gg = (u16*)(p.ws + WS_GG);
  e.xb = (float*)(p.ws + WS_XB); e.qg = p.in[18]; e.kg = p.in[19];
  e.outk = p.out + 6291456; e.outv = p.out + 8388608;
  const u16* A = (const u16*)(p.ws + WS_HNB);
  const u16* Bt = (const u16*)(p.ws + WS_WIN);
  for (int t = blockIdx.x; t < 48 * 20; t += gridDim.x)
    gemm_tile<EPI_INPROJ>(A, 1024, Bt, 1024, 1024, (t % 48) * 128, (t / 48) * 128, e, smem);
  {
    const int nb = gridDim.x, extra = (48 * 20) % nb, b = blockIdx.x;
    const TcPlan pl{{4544, 704, 0, 0}, {128, 384, 0, 0}};
    if (b >= extra) tc_run(p, smem, pl, b - extra, nb - extra);
  }
}

PHASE_FN void ph_attn(const Params& p, char* smem) {
  for (int t = blockIdx.x; t < 768; t += gridDim.x) { attn_item(t, p, smem); __syncthreads(); }
}
PHASE_FN void ph_lru1(const Params& p, char* smem) {
  const int nb = gridDim.x;
  for (int t = nb - 1 - (int)blockIdx.x; t < 768; t += nb) { lru1_item(t, p, smem); __syncthreads(); }
}
PHASE_FN void ph_lru2(const Params& p) {
  for (int t = blockIdx.x; t < 1536; t += gridDim.x) lru2_item(t, p);
}

PHASE_FN void ph_dftt(const Params& p, char* smem) {
  const u16* HNT = (const u16*)(p.ws + WS_HN);
  EpiP e{}; e.outb = (u16*)(p.ws + WS_Z2);
  const int nb = gridDim.x, b = blockIdx.x;
  for (int i = 0;; ++i) {
    int t;
    if (nb == 512) { if (b < 256) { if (i > 0) break; t = b; } else { if (i > 1) break; t = 256 + (b - 256) * 2 + i; } }
    else { t = b + i * nb; if (t >= 768) break; }
    const u16* A; int T, m0, n0;
    if (t < 256) { const int bb = t >> 7, r = t & 127; e.tok0 = NCTX + bb * 1024; T = 1024; A = (const u16*)(p.ws + WS_CT1024); m0 = (r & 15) * 128; n0 = (r >> 4) * 128; }
    else { const int t2 = t - 256, bb = t2 >> 5, r = t2 & 31; e.tok0 = bb * 256; T = 256; A = (const u16*)(p.ws + WS_CT256); m0 = (r & 3) * 128; n0 = (r >> 2) * 128; }
    e.T = T;
    gemm_tile<EPI_DFTT>(A, T, HNT + (size_t)e.tok0 * 1024, T, T, m0, n0, e, smem);
  }
}

PHASE_FN void ph_dftc(const Params& p, char* smem) {
  EpiP e{}; e.outb = (u16*)(p.ws + WS_F); e.ldc = 256;
  for (int t = blockIdx.x; t < 256 * 2; t += gridDim.x)
    gemm_tile<EPI_BF16, 1, 4, 3, 1>((const u16*)(p.ws + WS_Z2), 512, (const u16*)(p.ws + WS_CS2), 512, 512, (t >> 1) * 96, (t & 1) * 128, e, smem);
}

#ifndef REPMASK
#define REPMASK 0u
#define REPN 0
#endif
__device__ __forceinline__ int kind_of(int ph) {
  if (ph == 0) return K_PREP;
  if (ph <= 11) return ph;
  const int i = ph - 12;
  return i == 0 ? K_NORM0 : i == 1 ? K_GU1 : i == 2 ? K_DOWN1 : i == 3 ? K_NORMT : i == 4 ? K_DFTT : i == 5 ? K_DFTC :
         i == 6 ? K_OUTC : i == 7 ? K_NORM2 : i == 8 ? K_GU2 : K_DOWN2;
}
__device__ __forceinline__ void run_phase(int ph, int rep, const Params& p, char* smem) {
  int kind, l;
  if (ph == 0) { kind = K_PREP; l = 0; }
  else if (ph <= 11) { l = 0; kind = ph; }
  else {
    l = 1;
    const int i = ph - 12;
    kind = i == 0 ? K_NORM0 : i == 1 ? K_GU1 : i == 2 ? K_DOWN1 : i == 3 ? K_NORMT : i == 4 ? K_DFTT : i == 5 ? K_DFTC :
           i == 6 ? K_OUTC : i == 7 ? K_NORM2 : i == 8 ? K_GU2 : K_DOWN2;
  }
  switch (kind) {
    case K_PREP: ph_prep(p, smem); break;
    case K_NORM0: case K_NORM1: case K_NORM2: case K_NORMT: ph_norm(p, l, kind, smem); break;
    case K_GU1: ph_gu(p, l, 0, smem); break;
    case K_GU2: ph_gu(p, l, 1, smem); break;
    case K_DOWN1: case K_DOWN2: case K_OUTAB: case K_OUTC: ph_resid(p, l, kind, rep, smem); break;
    case K_INPROJ: ph_inproj(p, smem); break;
    case K_ATTLRU: ph_attn(p, smem); ph_lru1(p, smem); break;
    case K_LRU2: ph_lru2(p); break;
    case K_DFTT: ph_dftt(p, smem); break;
    case K_DFTC: ph_dftc(p, smem); break;
  }
}

__global__ void __launch_bounds__(256, 2) mega(Params p_) {
  __shared__ __attribute__((aligned(16))) char smem[SMEM_BYTES + 16];
  cg::grid_group grid = cg::this_grid();
  const int ph_lo = p_.ph_lo, ph_hi = p_.ph_hi, coop = p_.coop;
  volatile LAS unsigned* st = (volatile LAS unsigned*)(smem + SMEM_BYTES);
  if (threadIdx.x == 0) { st[0] = 0u; st[1] = 0u; st[2] = 0u; st[3] = 0u; }
  __syncthreads();
  XcdBarrier xb = xcd_barrier_post((unsigned*)(p_.ws + WS_BAR), st);
  for (int ph = ph_lo; ph < ph_hi; ++ph) {
    auto ka = __builtin_amdgcn_kernarg_segment_ptr();
    asm volatile("" : "+s"(ka));
    const Params& p = *(const Params*)ka;
    const int nrep = ((REPMASK >> kind_of(ph)) & 1u) ? 1 + REPN : 1;
    for (int rep = nrep - 1; rep >= 0; --rep) {
      run_phase(ph, rep, p, smem);
      if (ph + 1 < ph_hi || rep > 0) {
        const bool need_acq = (ph == 8 || ph == 11 || ph == 14 || ph == 18) || rep > 0;
        if (coop == 1) xcd_barrier(xb, need_acq);
        else if (coop == 2) grid.sync();
      }
    }
  }
}

extern "C" void kernel_launch(void* const* d_in, const int* in_sizes, int n_in, void* d_out, int out_size, void* d_ws,
                              size_t ws_size, hipStream_t stream) {
  static int grid_blocks = 0;
  if (!grid_blocks) {
    int dev = 0, cus = 0, per_cu = 0;
    hipGetDevice(&dev);
    hipDeviceGetAttribute(&cus, hipDeviceAttributeMultiprocessorCount, dev);
    hipOccupancyMaxActiveBlocksPerMultiprocessor(&per_cu, mega, 256, 0);
    if (per_cu > 2) per_cu = 2;
    if (per_cu < 1) per_cu = 1;
    grid_blocks = cus * per_cu;
    if (ws_size < WS_END) fprintf(stderr, "workspace too small: %zu < %zu\n", ws_size, (size_t)WS_END);
  }
  Params p{};
  for (int i = 0; i < 30; ++i) p.in[i] = (const float*)d_in[i];
  p.out = (float*)d_out;
  p.ws = (char*)d_ws;
#if ONE_LAUNCH
  p.ph_lo = 0; p.ph_hi = NPH; p.coop = 1;
  hipMemsetAsync((char*)d_ws + WS_BAR, 0, XCD_BAR_WORDS * 4, stream);
  void* args[] = {&p};
  hipError_t e = hipLaunchCooperativeKernel((void*)mega, dim3(grid_blocks), dim3(256), args, 0, stream);
  if (e != hipSuccess) fprintf(stderr, "cooperative launch failed: %s (grid %d)\n", hipGetErrorString(e), grid_blocks);
#else
  for (int ph = 0; ph < NPH; ++ph) {
    p.ph_lo = ph; p.ph_hi = ph + 1; p.coop = 0;
    hipLaunchKernelGGL(mega, dim3(grid_blocks), dim3(256), 0, stream, p);
  }
#endif
}
```

```cpp
#include <hip/hip_runtime.h>
#include <hip/hip_cooperative_groups.h>
#include <cstdio>
namespace cg = cooperative_groups;

typedef unsigned short u16;
using bf16x8 = __attribute__((ext_vector_type(8))) short;
using bf16x4 = __attribute__((ext_vector_type(4))) short;
using f32x16 = __attribute__((ext_vector_type(16))) float;
using f32x4 = __attribute__((ext_vector_type(4))) float;

#ifndef ONE_LAUNCH
#define ONE_LAUNCH 1
#endif

constexpr int NTOK = 6144, NCTX = 4096, DM = 1024, DFF = 2816;
constexpr int NPH = 22;

constexpr size_t WS_MOD = 0;
constexpr size_t WS_WGU = WS_MOD + 221184;
constexpr size_t WS_WD = WS_WGU + 4ull * 5632 * 1024 * 2;
constexpr size_t WS_WIN = WS_WD + 4ull * 1024 * 2816 * 2;
constexpr size_t WS_WOAB = WS_WIN + 2560ull * 1024 * 2;
constexpr size_t WS_WOC = WS_WOAB + 1024ull * 1024 * 2;
constexpr size_t WS_CKB = WS_WOC + 1024ull * 1024 * 2;
constexpr size_t WS_CVT = WS_CKB + 524288;
constexpr size_t WS_LRUW = WS_CVT + 524288;
constexpr size_t WS_CT256 = WS_LRUW + 262144;
constexpr size_t WS_CT1024 = WS_CT256 + 262144;
constexpr size_t WS_CS2 = WS_CT1024 + 4194304;
constexpr size_t WS_X = WS_CS2 + 262144;
constexpr size_t WS_HN = WS_X + 6144ull * 1024 * 4;
constexpr size_t WS_H = WS_HN + 6144ull * 1024 * 2;
constexpr size_t WS_Q = WS_H + 6144ull * 2816 * 2;
constexpr size_t WS_K = WS_Q + 6144ull * 512 * 2;
constexpr size_t WS_VT = WS_K + 6144ull * 512 * 2;
constexpr size_t WS_XB = WS_VT + 6144ull * 512 * 2;
constexpr size_t WS_GG = WS_XB + 6144ull * 512 * 4;
constexpr size_t WS_MIX = WS_GG + 6144ull * 512 * 2;
constexpr size_t WS_Z = WS_MIX + 6144ull * 1024 * 2;
constexpr size_t WS_AGGA = WS_Z + 6144ull * 2048 * 2;
constexpr size_t WS_AGGH = WS_AGGA + 393216;
constexpr size_t WS_BAR = WS_AGGH + 393216;
constexpr size_t WS_HL = WS_BAR + 16384;
constexpr size_t WS_Z2 = WS_HL + 2ull * 6144 * 512 * 4;
constexpr size_t WS_F = WS_Z;
constexpr size_t WS_HNB = WS_Z2 + 6144ull * 2048 * 2;
constexpr size_t WS_END = WS_HNB + 6144ull * 1024 * 2;

constexpr int SMEM_BYTES = 81920 - 16;

struct Params {
  const float* in[30];
  float* out;
  char* ws;
  int ph_lo, ph_hi, coop, pad;
};

struct EpiP {
  float* outf; u16* outb; int ldc; int tok0;
  const float* res0; const float* res1;
  const float* gate; float gscale; int T;
  u16 *q, *k, *vT, *gg; float* xb;
  const float *qg, *kg; float *outk, *outv;
};

__device__ __forceinline__ u16 f2bf(float f) {
  unsigned u = __float_as_uint(f);
  u += 0x7fffu + ((u >> 16) & 1u);
  return (u16)(u >> 16);
}
__device__ __forceinline__ unsigned pack2(float a, float b) { return (unsigned)f2bf(a) | ((unsigned)f2bf(b) << 16); }
__device__ __forceinline__ float bf2f(u16 v) { return __uint_as_float(((unsigned)v) << 16); }
__device__ __forceinline__ float sigmoidf_(float x) { return 1.f / (1.f + __expf(-x)); }
__device__ __forceinline__ int cond_of(int row) { return row < NCTX ? 0 : 1 + ((row - NCTX) >> 10); }

__device__ __forceinline__ int TID() { int t = __builtin_amdgcn_workitem_id_x(); asm volatile("" : "+v"(t)); return t; }

__device__ __forceinline__ void st_wt(u16* p, u16 v) { __hip_atomic_store(p, v, __ATOMIC_RELAXED, __HIP_MEMORY_SCOPE_AGENT); }
__device__ __forceinline__ void st_wt(float* p, float v) { *p = v; }
__device__ __forceinline__ void st_wt(uint2* p, uint2 v) {
  unsigned long long w = (unsigned long long)v.x | ((unsigned long long)v.y << 32);
  __hip_atomic_store((unsigned long long*)p, w, __ATOMIC_RELAXED, __HIP_MEMORY_SCOPE_AGENT);
}

enum { EPI_SWIGLU = 0, EPI_RESID = 1, EPI_INPROJ = 2, EPI_DFTT = 3, EPI_BF16 = 4 };

template <int EPI, int WR = 2, int WC = 2, int MI = 2, int NI = 2>
__device__ __forceinline__ void gemm_tile(const u16* __restrict__ A, int lda, const u16* __restrict__ Bt, int ldb,
                                          int K, int m0, int n0, const EpiP& e, char* smem) {
  constexpr int TM = WR * MI * 32, TN = WC * NI * 32, NA = TM / 32, NB = TN / 32;
  static_assert(WR * WC == 4, "4 waves");
  static_assert(EPI == EPI_RESID || EPI == EPI_BF16 || (WR == 2 && WC == 2 && NI == 2 && (MI == 2 || EPI == EPI_SWIGLU)), "tile config not supported by this epilogue");
  typedef unsigned v4u __attribute__((ext_vector_type(4)));
  const int tid = TID(), lane = tid & 63, wid = tid >> 6, wr = wid / WC, wc = wid % WC;
  u16* sA = (u16*)smem;
  u16* sB = sA + 2 * TM * 72;
  f32x16 acc[MI][NI];
#pragma unroll
  for (int i = 0; i < MI; ++i)
#pragma unroll
    for (int j = 0; j < NI; ++j)
#pragma unroll
      for (int r = 0; r < 16; ++r) acc[i][j][r] = 0.f;
  typedef __attribute__((address_space(3))) void* lds_ptr_t;
  const int lr8 = lane >> 3, lp = lane & 7;
  const int nk = K >> 6;
  const u16* gA[NA]; const u16* gB[NB];
#pragma unroll
  for (int j = 0; j < NA; ++j) { const int r = 8 * (j * 4 + wid) + lr8; gA[j] = A + (size_t)(m0 + r) * lda + ((lp ^ ((r >> 1) & 7)) << 3); }
#pragma unroll
  for (int j = 0; j < NB; ++j) { const int r = 8 * (j * 4 + wid) + lr8; gB[j] = Bt + (size_t)(n0 + r) * ldb + ((lp ^ ((r >> 1) & 7)) << 3); }
  char* const sAl = smem + wid * 1024 + lane * 16;
  char* const sBl = smem + 2 * TM * 128 + wid * 1024 + lane * 16;
#define G_ISSUE(BUF, KO) { \
    _Pragma("unroll") for (int j = 0; j < NA; ++j) __builtin_amdgcn_global_load_lds((const void*)(gA[j] + (KO)), (lds_ptr_t)(sAl + (BUF) * TM * 128 + j * 4096), 16, 0, 0); \
    _Pragma("unroll") for (int j = 0; j < NB; ++j) __builtin_amdgcn_global_load_lds((const void*)(gB[j] + (KO)), (lds_ptr_t)(sBl + (BUF) * TN * 128 + j * 4096), 16, 0, 0); }
  const int fsw = ((lane & 31) >> 1) & 7;
#define G_COMPUTE(BUF) { \
    const char* a_base = smem + (BUF) * TM * 128 + (wr * MI * 32 + (lane & 31)) * 128; \
    const char* b_base = smem + 2 * TM * 128 + (BUF) * TN * 128 + (wc * NI * 32 + (lane & 31)) * 128; \
    _Pragma("unroll") for (int ks = 0; ks < 4; ++ks) { \
      const int co = ((ks * 2 + (lane >> 5)) ^ fsw) << 4; \
      bf16x8 af[MI], bfr[NI]; \
      _Pragma("unroll") for (int mi = 0; mi < MI; ++mi) af[mi] = *(const bf16x8*)(a_base + mi * 32 * 128 + co); \
      _Pragma("unroll") for (int ni = 0; ni < NI; ++ni) bfr[ni] = *(const bf16x8*)(b_base + ni * 32 * 128 + co); \
      _Pragma("unroll") for (int mi = 0; mi < MI; ++mi) \
        _Pragma("unroll") for (int ni = 0; ni < NI; ++ni) \
          acc[mi][ni] = __builtin_amdgcn_mfma_f32_32x32x16_bf16(af[mi], bfr[ni], acc[mi][ni], 0, 0, 0); } }
  G_ISSUE(0, 0)
  asm volatile("s_waitcnt vmcnt(0)" ::: "memory");
  __syncthreads();
  for (int kt = 0; kt < nk; kt += 2) {
    G_ISSUE(1, (kt + 1) * 64)
    G_COMPUTE(0)
    asm volatile("s_waitcnt vmcnt(0)" ::: "memory");
    __syncthreads();
    if (kt + 2 < nk) { G_ISSUE(0, (kt + 2) * 64) }
    G_COMPUTE(1)
    asm volatile("s_waitcnt vmcnt(0)" ::: "memory");
    __syncthreads();
  }
#undef G_ISSUE
#undef G_COMPUTE
  const int l31 = lane & 31, lh = lane >> 5;
  if constexpr (EPI == EPI_SWIGLU) {
    const int colh = (n0 >> 1) + wc * 32 + l31;
#pragma unroll
    for (int mi = 0; mi < MI; ++mi)
#pragma unroll
      for (int r = 0; r < 16; ++r) {
        const int row = m0 + wr * (MI * 32) + mi * 32 + (r & 3) + 8 * (r >> 2) + 4 * lh;
        const float g = acc[mi][0][r], u = acc[mi][1][r];
        e.outb[(size_t)row * DFF + colh] = f2bf(g * sigmoidf_(g) * u);
      }
  } else if constexpr (EPI == EPI_RESID) {
    const float* res1m = e.res1 - (size_t)NCTX * DM;
    float g3[NI][3];
#pragma unroll
    for (int ni = 0; ni < NI; ++ni)
#pragma unroll
      for (int c = 0; c < 3; ++c) g3[ni][c] = e.gscale * e.gate[c * 9216 + n0 + wc * (NI * 32) + ni * 32 + l31];
    float rv[MI][NI][16];
#pragma unroll
    for (int mi = 0; mi < MI; ++mi)
#pragma unroll
      for (int r = 0; r < 16; ++r) {
        const int row = m0 + wr * (MI * 32) + mi * 32 + (r & 3) + 8 * (r >> 2) + 4 * lh;
        const float* rp = (row < NCTX ? e.res0 : res1m) + (size_t)row * DM;
#pragma unroll
        for (int ni = 0; ni < NI; ++ni) rv[mi][ni][r] = rp[n0 + wc * (NI * 32) + ni * 32 + l31];
      }
    asm volatile("" ::: "memory"); __builtin_amdgcn_sched_barrier(0);
#pragma unroll
    for (int mi = 0; mi < MI; ++mi)
#pragma unroll
      for (int r = 0; r < 16; ++r) {
        const int row = m0 + wr * (MI * 32) + mi * 32 + (r & 3) + 8 * (r >> 2) + 4 * lh;
        const int c = cond_of(row);
#pragma unroll
        for (int ni = 0; ni < NI; ++ni) {
          const int col = n0 + wc * (NI * 32) + ni * 32 + l31;
          const float gg_ = c == 0 ? g3[ni][0] : (c == 1 ? g3[ni][1] : g3[ni][2]);
          st_wt(&e.outf[(size_t)row * DM + col], rv[mi][ni][r] + gg_ * acc[mi][ni][r]);
        }
      }
  } else if constexpr (EPI == EPI_INPROJ) {
    const int sec = n0 >> 9;
    const int cb = (n0 & 511) + wc * 64;
    if (sec <= 1) {
      const float* gv = sec == 0 ? e.qg : e.kg;
      const float g0 = gv[l31], g1 = gv[32 + l31];
      const float sc = sec == 0 ? 0.125f : 1.f;
#pragma unroll
      for (int mi = 0; mi < 2; ++mi)
#pragma unroll
        for (int r = 0; r < 16; ++r) {
          const int row = m0 + wr * 64 + mi * 32 + (r & 3) + 8 * (r >> 2) + 4 * lh;
          const float v0 = acc[mi][0][r], v1 = acc[mi][1][r];
          float ss = v0 * v0 + v1 * v1;
          ss += __shfl_xor(ss, 1); ss += __shfl_xor(ss, 2); ss += __shfl_xor(ss, 4);
          ss += __shfl_xor(ss, 8); ss += __shfl_xor(ss, 16);
          const float rs = rsqrtf(ss * (1.f / 64.f) + 1e-6f) * sc;
          const float o0 = v0 * rs * g0, o1 = v1 * rs * g1;
          u16* dst = (sec == 0 ? e.q : e.k) + (size_t)row * 512 + cb;
          dst[l31] = f2bf(o0); dst[32 + l31] = f2bf(o1);
          if (sec == 1 && row < NCTX) {
            __builtin_nontemporal_store(o0, &e.outk[(size_t)row * 512 + cb + l31]);
            __builtin_nontemporal_store(o1, &e.outk[(size_t)row * 512 + cb + 32 + l31]);
          }
        }
    } else if (sec == 2) {
#pragma unroll
      for (int mi = 0; mi < 2; ++mi)
#pragma unroll
        for (int ni = 0; ni < 2; ++ni) {
          const int col = cb + ni * 32 + l31;
#pragma unroll
          for (int q4 = 0; q4 < 4; ++q4) {
            const int row = m0 + wr * 64 + mi * 32 + 8 * q4 + 4 * lh;
            uint2 pk;
            pk.x = pack2(acc[mi][ni][4 * q4 + 0], acc[mi][ni][4 * q4 + 1]);
            pk.y = pack2(acc[mi][ni][4 * q4 + 2], acc[mi][ni][4 * q4 + 3]);
            *(uint2*)(e.vT + (size_t)col * NTOK + row) = pk;
            if (row < NCTX) {
#pragma unroll
              for (int j = 0; j < 4; ++j) __builtin_nontemporal_store(acc[mi][ni][4 * q4 + j], &e.outv[(size_t)(row + j) * 512 + col]);
            }
          }
        }
    } else {
#pragma unroll
      for (int mi = 0; mi < 2; ++mi)
#pragma unroll
        for (int r = 0; r < 16; ++r) {
          const int row = m0 + wr * 64 + mi * 32 + (r & 3) + 8 * (r >> 2) + 4 * lh;
#pragma unroll
          for (int ni = 0; ni < 2; ++ni) {
            const int col = cb + ni * 32 + l31;
            const float v = acc[mi][ni][r];
            if (sec == 3) __builtin_nontemporal_store(v, &e.xb[(size_t)row * 512 + col]);
            else {
              const float t = tanhf(0.7978845608028654f * (v + 0.044715f * v * v * v));
              e.gg[(size_t)row * 512 + col] = f2bf(0.5f * v * (1.f + t));
            }
          }
        }
    }
  } else if constexpr (EPI == EPI_DFTT) {
#pragma unroll
    for (int mi = 0; mi < 2; ++mi)
#pragma unroll
      for (int r = 0; r < 16; ++r) {
        const int m = m0 + wr * 64 + mi * 32 + (r & 3) + 8 * (r >> 2) + 4 * lh;
        const int cs = m >= e.T ? 1 : 0;
        const int kt = m - cs * e.T;
#pragma unroll
        for (int ni = 0; ni < 2; ++ni) {
          const int d = n0 + wc * 64 + ni * 32 + l31;
          __builtin_nontemporal_store(f2bf(acc[mi][ni][r]), &e.outb[(size_t)(e.tok0 + kt) * 2048 + (d >> 8) * 512 + cs * 256 + (d & 255)]);
        }
      }
  } else {
#pragma unroll
    for (int mi = 0; mi < MI; ++mi)
#pragma unroll
      for (int r = 0; r < 16; ++r) {
        const int row = m0 + wr * (MI * 32) + mi * 32 + (r & 3) + 8 * (r >> 2) + 4 * lh;
#pragma unroll
        for (int ni = 0; ni < NI; ++ni) {
          const int col = n0 + wc * (NI * 32) + ni * 32 + l31;
          e.outb[(size_t)row * e.ldc + col] = f2bf(acc[mi][ni][r]);
        }
      }
  }
}

__device__ __forceinline__ void tc_tile(const float* __restrict__ src, int lds_, u16* __restrict__ dst, int ldd,
                                        int k0, int n0, int mode, float* sT) {
  const int tid = TID();
  const int r = tid >> 4, c4 = (tid & 15) * 4;
#pragma unroll
  for (int p = 0; p < 4; ++p) {
    const float4 v = *(const float4*)(src + (size_t)(k0 + r + 16 * p) * lds_ + n0 + c4);
    float* d = sT + (r + 16 * p) * 65 + c4;
    d[0] = v.x; d[1] = v.y; d[2] = v.z; d[3] = v.w;
  }
  __syncthreads();
  const int n = tid >> 2, kq = (tid & 3) * 16;
  unsigned w[8];
#pragma unroll
  for (int j = 0; j < 8; ++j) w[j] = pack2(sT[(kq + 2 * j) * 65 + n], sT[(kq + 2 * j + 1) * 65 + n]);
  const int gn = n0 + n;
  const int drow = mode == 0 ? gn : ((gn >> 5) * 64 + (mode - 1) * 32 + (gn & 31));
  uint4* dp = (uint4*)(dst + (size_t)drow * ldd + k0 + kq);
  dp[0] = make_uint4(w[0], w[1], w[2], w[3]);
  dp[1] = make_uint4(w[4], w[5], w[6], w[7]);
  __syncthreads();
}

__device__ __forceinline__ void mod_item(int item, const Params& p, char* smem) {
  const int l = item / 144, cb = item % 144;
  const int tid = TID();
  float* sS = (float*)smem;
  float* sR = sS + 3072;
  {
    float cv[12];
#pragma unroll
    for (int q = 0; q < 12; ++q) {
      const int i = tid + 256 * q, ci = i >> 10, k = i & 1023;
      const float* src = ci == 0 ? p.in[7] : p.in[6] + (ci - 1) * 1024;
      cv[q] = src[k];
    }
    asm volatile("" ::: "memory"); __builtin_amdgcn_sched_barrier(0);
#pragma unroll
    for (int q = 0; q < 12; ++q) sS[tid + 256 * q] = cv[q] * sigmoidf_(cv[q]);
  }
  __syncthreads();
  const int c4 = (tid & 15) * 4, ks = tid >> 4;
  float acc[3][4];
#pragma unroll
  for (int a = 0; a < 3; ++a)
#pragma unroll
    for (int b = 0; b < 4; ++b) acc[a][b] = 0.f;
  const float* wp = p.in[8] + ((size_t)l * 1024 + ks * 64) * 9216 + cb * 64 + c4;
  typedef float v4f __attribute__((ext_vector_type(4)));
  for (int kk0 = 0; kk0 < 64; kk0 += 16) {
    v4f w[16];
#pragma unroll
    for (int i = 0; i < 16; ++i) w[i] = __builtin_nontemporal_load((const v4f*)(wp + (size_t)(kk0 + i) * 9216));
    asm volatile("" ::: "memory"); __builtin_amdgcn_sched_barrier(0);
#pragma unroll
    for (int i = 0; i < 16; ++i) {
      const int k = ks * 64 + kk0 + i;
#pragma unroll
      for (int ci = 0; ci < 3; ++ci) {
        const float s = sS[ci * 1024 + k];
        acc[ci][0] += s * w[i].x; acc[ci][1] += s * w[i].y; acc[ci][2] += s * w[i].z; acc[ci][3] += s * w[i].w;
      }
    }
  }
#pragma unroll
  for (int ci = 0; ci < 3; ++ci)
#pragma unroll
    for (int b = 0; b < 4; ++b) sR[(ks * 3 + ci) * 64 + c4 + b] = acc[ci][b];
  __syncthreads();
  if (tid < 192) {
    const int ci = tid >> 6, cc = tid & 63;
    float s = p.in[9][l * 9216 + cb * 64 + cc];
#pragma unroll
    for (int k2 = 0; k2 < 16; ++k2) s += sR[(k2 * 3 + ci) * 64 + cc];
    ((float*)(p.ws + WS_MOD))[(l * 3 + ci) * 9216 + cb * 64 + cc] = s;
  }
  __syncthreads();
}

struct TcJob { const float* src; u16* dst; int lds_, ldd, k0, n0, mode; };
__device__ __forceinline__ TcJob tc_decode(int t, const Params& p) {
  TcJob j;
  if (t < 2816) {
    const int m = t / 704, rem = t % 704, isup = rem / 352, tt = rem % 352;
    const int l = m >> 1, f = m & 1;
    j.src = p.in[f == 0 ? (isup ? 12 : 11) : (isup ? 15 : 14)] + (size_t)l * 1024 * DFF; j.lds_ = DFF;
    j.dst = (u16*)(p.ws + WS_WGU) + (size_t)m * 5632 * 1024; j.ldd = 1024;
    j.k0 = (tt / 22) * 64; j.n0 = (tt % 22) * 128; j.mode = 1 + isup;
    return j;
  }
  t -= 2816;
  if (t < 1408) {
    const int m = t / 352, tt = t % 352;
    const int l = m >> 1, f = m & 1;
    j.src = p.in[f == 0 ? 13 : 16] + (size_t)l * DFF * 1024; j.lds_ = 1024;
    j.dst = (u16*)(p.ws + WS_WD) + (size_t)m * 1024 * DFF; j.ldd = DFF;
    j.k0 = (tt / 8) * 64; j.n0 = (tt % 8) * 128; j.mode = 0;
    return j;
  }
  t -= 1408;
  if (t < 320) { j.src = p.in[17]; j.lds_ = 2560; j.dst = (u16*)(p.ws + WS_WIN); j.ldd = 1024; j.k0 = (t / 20) * 64; j.n0 = (t % 20) * 128; j.mode = 0; return j; }
  t -= 320;
  if (t < 128) { j.src = p.in[28]; j.lds_ = 1024; j.dst = (u16*)(p.ws + WS_WOAB); j.ldd = 1024; j.k0 = (t / 8) * 64; j.n0 = (t % 8) * 128; j.mode = 0; return j; }
  t -= 128;
  if (t < 128) { j.src = p.in[29]; j.lds_ = 1024; j.dst = (u16*)(p.ws + WS_WOC); j.ldd = 1024; j.k0 = (t / 8) * 64; j.n0 = (t % 8) * 128; j.mode = 0; return j; }
  t -= 128;
  {
    const int b = t / 16, r = t % 16;
    j.src = p.in[3] + (size_t)b * 256 * 512; j.lds_ = 512; j.dst = (u16*)(p.ws + WS_CVT) + (size_t)b * 512 * 256; j.ldd = 256;
    j.k0 = (r / 4) * 64; j.n0 = (r % 4) * 128; j.mode = 0;
    return j;
  }
}
constexpr int N_TC = 2816 + 1408 + 320 + 128 + 128 + 32;

struct TcPlan { int s[4]; int n[4]; };
__device__ __forceinline__ int tc_map(const TcPlan& pl, int v) {
#pragma unroll
  for (int i = 0; i < 4; ++i) { if (v < pl.n[i]) return pl.s[i] + v; v -= pl.n[i]; }
  return -1;
}
__device__ __forceinline__ void tc_run(const Params& p, char* smem, const TcPlan& pl, int rank, int nranks) {
  float* sT = (float*)smem;
  const int total = pl.n[0] + pl.n[1] + pl.n[2] + pl.n[3];
  const int tid = TID();
  const int lr = tid >> 5, lc4 = (tid & 31) * 4;
  typedef float v4f_nt __attribute__((ext_vector_type(4)));
  v4f_nt v[8];
  TcJob cur{}, nxt{};
  int t = rank;
  bool have = t < total;
  if (have) {
    cur = tc_decode(tc_map(pl, t), p);
#pragma unroll
    for (int q = 0; q < 8; ++q) v[q] = __builtin_nontemporal_load((const v4f_nt*)(cur.src + (size_t)(cur.k0 + lr + 8 * q) * cur.lds_ + cur.n0 + lc4));
  }
  while (have) {
#pragma unroll
    for (int q = 0; q < 8; ++q) {
      float* d = sT + (lr + 8 * q) * 129 + lc4;
      d[0] = v[q].x; d[1] = v[q].y; d[2] = v[q].z; d[3] = v[q].w;
    }
    __syncthreads();
    const int tn = t + nranks;
    const bool haven = tn < total;
    if (haven) {
      nxt = tc_decode(tc_map(pl, tn), p);
#pragma unroll
      for (int q = 0; q < 8; ++q) v[q] = __builtin_nontemporal_load((const v4f_nt*)(nxt.src + (size_t)(nxt.k0 + lr + 8 * q) * nxt.lds_ + nxt.n0 + lc4));
    }
    {
      const int n = tid & 127, kq = (tid >> 7) * 32;
      unsigned w[16];
#pragma unroll
      for (int j = 0; j < 16; ++j) w[j] = pack2(sT[(kq + 2 * j) * 129 + n], sT[(kq + 2 * j + 1) * 129 + n]);
      const int gn = cur.n0 + n;
      const int drow = cur.mode == 0 ? gn : ((gn >> 5) * 64 + (cur.mode - 1) * 32 + (gn & 31));
      uint4* dp = (uint4*)(cur.dst + (size_t)drow * cur.ldd + cur.k0 + kq);
      dp[0] = make_uint4(w[0], w[1], w[2], w[3]);
      dp[1] = make_uint4(w[4], w[5], w[6], w[7]);
      dp[2] = make_uint4(w[8], w[9], w[10], w[11]);
      dp[3] = make_uint4(w[12], w[13], w[14], w[15]);
    }
    __syncthreads();
    cur = nxt; t = tn; have = haven;
  }
}

__device__ void phase_prep(const Params& p, char* smem) {
  float* sT = (float*)smem;
  const int b = blockIdx.x, nb = gridDim.x;
  for (int t = b; t < 288; t += nb) mod_item(t, p, smem);
  for (int t = b; t < 32; t += nb) {
    const int dir = t / 16, blk = (t / 2) % 8, gate = t % 2;
    tc_tile(p.in[gate ? 25 : 23] + (size_t)(dir * 8 + blk) * 4096, 64,
            (u16*)(p.ws + WS_LRUW) + (size_t)((dir * 8 + blk) * 2 + gate) * 4096, 64, 0, 0, 0, sT);
  }
  {
    const TcPlan pl{{0, 4800, 0, 0}, {704, 32, 0, 0}};
    if (nb > 352) { if (b >= 288) tc_run(p, smem, pl, b - 288, nb - 288); }
    else tc_run(p, smem, pl, b, nb);
  }
  const int gt = blockIdx.x * 256 + TID(), gs = gridDim.x * 256;
  u16* ct256 = (u16*)(p.ws + WS_CT256);
  for (int i = gt; i < 512 * 256; i += gs) {
    const int m = i >> 8, t = i & 255, cs = m >> 8, kt = m & 255;
    const float ang = 2.f * (float)((kt * t) & 255) * (1.f / 256.f);
    ct256[i] = f2bf((cs ? sinpif(ang) : cospif(ang)) * 0.0625f);
  }
  u16* ct1024 = (u16*)(p.ws + WS_CT1024);
  for (int i = gt; i < 2048 * 1024; i += gs) {
    const int m = i >> 10, t = i & 1023, cs = m >> 10, kt = m & 1023;
    const float ang = 2.f * (float)((kt * t) & 1023) * (1.f / 1024.f);
    ct1024[i] = f2bf((cs ? sinpif(ang) : cospif(ang)) * 0.03125f);
  }
  u16* cs2 = (u16*)(p.ws + WS_CS2);
  for (int i = gt; i < 256 * 512; i += gs) {
    const int kc = i >> 9, r = i & 511, cs = r >> 8, c = r & 255;
    const float ang = 2.f * (float)((kc * c) & 255) * (1.f / 256.f);
    cs2[i] = f2bf((cs ? -sinpif(ang) : cospif(ang)) * 0.0625f);
  }
  u16* ckb = (u16*)(p.ws + WS_CKB);
  for (int i = gt; i < 2 * 256 * 512; i += gs) ckb[i] = f2bf(p.in[2][i]);
}

__device__ __forceinline__ const float* xrow(const float* x0, const float* x1, int row) {
  return (row < NCTX ? x0 : x1 - (size_t)NCTX * DM) + (size_t)row * DM;
}

__device__ void phase_norm(const Params& p, const float* x0, const float* x1, int l, int which) {
  const int lane = TID() & 63, wid = TID() >> 6;
  const float* g = p.in[10] + (l * 3 + which) * 1024;
  const float* mod = (const float*)(p.ws + WS_MOD) + (size_t)l * 3 * 9216 + which * 3 * 1024;
  u16* hn = (u16*)(p.ws + (((l * 3 + which) & 1) ? WS_HNB : WS_HN));
  const int nw = gridDim.x * 4;
  float4 gv[4];
#pragma unroll
  for (int j = 0; j < 4; ++j) gv[j] = *(const float4*)(g + j * 256 + lane * 4);
  for (int base = blockIdx.x * 4 + wid; base < NTOK; base += 3 * nw) {
    float4 v[3][4], sh[3][4], sc[3][4];
#pragma unroll
    for (int j3 = 0; j3 < 3; ++j3) {
      int row = base + j3 * nw; row = row < NTOK ? row : NTOK - 1;
      const float* xr = xrow(x0, x1, row);
      const float* mp = mod + cond_of(row) * 9216;
#pragma unroll
      for (int j = 0; j < 4; ++j) {
        v[j3][j] = *(const float4*)(xr + j * 256 + lane * 4);
        sh[j3][j] = *(const float4*)(mp + j * 256 + lane * 4);
        sc[j3][j] = *(const float4*)(mp + 1024 + j * 256 + lane * 4);
      }
    }
    asm volatile("" : "+v"(v[1][0].x), "+v"(v[1][1].x), "+v"(v[1][2].x), "+v"(v[1][3].x), "+v"(v[2][0].x), "+v"(v[2][1].x), "+v"(v[2][2].x), "+v"(v[2][3].x),
                      "+v"(sh[1][0].x), "+v"(sh[1][1].x), "+v"(sh[1][2].x), "+v"(sh[1][3].x), "+v"(sh[2][0].x), "+v"(sh[2][1].x), "+v"(sh[2][2].x), "+v"(sh[2][3].x),
                      "+v"(sc[1][0].x), "+v"(sc[1][1].x), "+v"(sc[1][2].x), "+v"(sc[1][3].x), "+v"(sc[2][0].x), "+v"(sc[2][1].x), "+v"(sc[2][2].x), "+v"(sc[2][3].x));
#pragma unroll
    for (int j3 = 0; j3 < 3; ++j3) {
      const int row = base + j3 * nw;
      float ss = 0.f;
#pragma unroll
      for (int j = 0; j < 4; ++j) ss += v[j3][j].x * v[j3][j].x + v[j3][j].y * v[j3][j].y + v[j3][j].z * v[j3][j].z + v[j3][j].w * v[j3][j].w;
#pragma unroll
      for (int o = 1; o < 64; o <<= 1) ss += __shfl_xor(ss, o);
      const float rs = rsqrtf(ss * (1.f / 1024.f) + 1e-6f);
      if (row < NTOK) {
#pragma unroll
        for (int j = 0; j < 4; ++j) {
          const int c = j * 256 + lane * 4;
          uint2 pk;
          pk.x = pack2(v[j3][j].x * rs * gv[j].x * (1.f + sc[j3][j].x) + sh[j3][j].x, v[j3][j].y * rs * gv[j].y * (1.f + sc[j3][j].y) + sh[j3][j].y);
          pk.y = pack2(v[j3][j].z * rs * gv[j].z * (1.f + sc[j3][j].z) + sh[j3][j].z, v[j3][j].w * rs * gv[j].w * (1.f + sc[j3][j].w) + sh[j3][j].w);
          st_wt((uint2*)(hn + (size_t)row * DM + c), pk);
        }
      }
    }
  }
}

__device__ void phase_normT(const Params& p, const float* x0, const float* x1, int l, int which, char* smem) {
  const int tid = TID(), lane = tid & 63, wid = tid >> 6;
  const float* g = p.in[10] + (l * 3 + which) * 1024;
  const float* mod = (const float*)(p.ws + WS_MOD) + (size_t)l * 3 * 9216 + which * 3 * 1024;
  u16* hnT = (u16*)(p.ws + (((l * 3 + which) & 1) ? WS_HNB : WS_HN));
  u16* sT = (u16*)smem;
  float4 gv[4];
#pragma unroll
  for (int j = 0; j < 4; ++j) gv[j] = *(const float4*)(g + j * 256 + lane * 4);
  for (int item = blockIdx.x; item < NTOK / 32; item += gridDim.x) {
    const int tokb = item * 32;
    for (int rr0 = wid; rr0 < 32; rr0 += 8) {
      float4 v[2][4], sh[2][4], sc[2][4];
#pragma unroll
      for (int q = 0; q < 2; ++q) {
        const int row = tokb + rr0 + 4 * q;
        const float* xr = xrow(x0, x1, row);
        const float* mp = mod + cond_of(row) * 9216;
#pragma unroll
        for (int j = 0; j < 4; ++j) {
          v[q][j] = *(const float4*)(xr + j * 256 + lane * 4);
          sh[q][j] = *(const float4*)(mp + j * 256 + lane * 4);
          sc[q][j] = *(const float4*)(mp + 1024 + j * 256 + lane * 4);
        }
      }
      asm volatile("" : "+v"(v[0][0].x), "+v"(v[0][1].x), "+v"(v[0][2].x), "+v"(v[0][3].x), "+v"(v[1][0].x), "+v"(v[1][1].x), "+v"(v[1][2].x), "+v"(v[1][3].x),
                        "+v"(sh[0][0].x), "+v"(sh[0][1].x), "+v"(sh[0][2].x), "+v"(sh[0][3].x), "+v"(sh[1][0].x), "+v"(sh[1][1].x), "+v"(sh[1][2].x), "+v"(sh[1][3].x),
                        "+v"(sc[0][0].x), "+v"(sc[0][1].x), "+v"(sc[0][2].x), "+v"(sc[0][3].x), "+v"(sc[1][0].x), "+v"(sc[1][1].x), "+v"(sc[1][2].x), "+v"(sc[1][3].x));
#pragma unroll
      for (int q = 0; q < 2; ++q) {
        const int rr = rr0 + 4 * q;
        float ss = 0.f;
#pragma unroll
        for (int j = 0; j < 4; ++j) ss += v[q][j].x * v[q][j].x + v[q][j].y * v[q][j].y + v[q][j].z * v[q][j].z + v[q][j].w * v[q][j].w;
#pragma unroll
        for (int o = 1; o < 64; o <<= 1) ss += __shfl_xor(ss, o);
        const float rs = rsqrtf(ss * (1.f / 1024.f) + 1e-6f);
#pragma unroll
        for (int j = 0; j < 4; ++j) {
          const int c = j * 256 + lane * 4;
          u16* d = sT + rr * 1026 + c;
          d[0] = f2bf(v[q][j].x * rs * gv[j].x * (1.f + sc[q][j].x) + sh[q][j].x);
          d[1] = f2bf(v[q][j].y * rs * gv[j].y * (1.f + sc[q][j].y) + sh[q][j].y);
          d[2] = f2bf(v[q][j].z * rs * gv[j].z * (1.f + sc[q][j].z) + sh[q][j].z);
          d[3] = f2bf(v[q][j].w * rs * gv[j].w * (1.f + sc[q][j].w) + sh[q][j].w);
        }
      }
    }
    __syncthreads();
    int base, T, t0;
    if (tokb < NCTX) { base = (tokb >> 8) << 8; T = 256; t0 = tokb & 255; }
    else { base = NCTX + (((tokb - NCTX) >> 10) << 10); T = 1024; t0 = (tokb - NCTX) & 1023; }
#pragma unroll 4
    for (int it = 0; it < 16; ++it) {
      const int u = tid + 256 * it;
      const int d = u & 1023, tq = u >> 10;
      unsigned w[4];
#pragma unroll
      for (int j = 0; j < 4; ++j)
        w[j] = (unsigned)sT[(tq * 8 + 2 * j) * 1026 + d] | ((unsigned)sT[(tq * 8 + 2 * j + 1) * 1026 + d] << 16);
      *(uint4*)(hnT + (size_t)base * 1024 + (size_t)d * T + t0 + tq * 8) = make_uint4(w[0], w[1], w[2], w[3]);
    }
    __syncthreads();
  }
}

__device__ __forceinline__ void attn_item(int item, const Params& p, char* smem) {
  const int tid = TID(), lane = tid & 63, w = tid >> 6, l15 = lane & 15, g = lane >> 4;
  u16* sQ = (u16*)smem;
  u16* sK = sQ + 64 * 72;
  u16* sV = sK + 64 * 72;
  float* sRpb = (float*)(sQ + 5 * 64 * 72);
  const u16* QB = (const u16*)(p.ws + WS_Q);
  const u16* KB = (const u16*)(p.ws + WS_K);
  const u16* VT = (const u16*)(p.ws + WS_VT);
  const u16* CKB = (const u16*)(p.ws + WS_CKB);
  const u16* CVT = (const u16*)(p.ws + WS_CVT);
  u16* MIX = (u16*)(p.ws + WS_MIX);
  bool sample; int b, h, r = 0, rs = 0, tokq0, tok0, ntiles;
  if (item < 256) { sample = true; b = item >> 7; h = (item >> 4) & 7; r = item & 15; tok0 = NCTX + b * 1024; tokq0 = tok0 + r * 64; ntiles = 12;
    rs = r - 4; rs = rs < 0 ? 0 : (rs > 8 ? 8 : rs); }
  else { const int it = item - 256; sample = false; b = it >> 5; h = (it >> 2) & 7; tok0 = b * 256; tokq0 = tok0 + (it & 3) * 64; ntiles = 4; }
  const int lrow = tid >> 3, lseg = tid & 7;
#pragma unroll
  for (int i = 0; i < 2; ++i)
    *(uint4*)(sQ + (lrow + 32 * i) * 72 + lseg * 8) = *(const uint4*)(QB + (size_t)(tokq0 + lrow + 32 * i) * 512 + h * 64 + lseg * 8);
  if (sample) for (int i = tid; i < 465; i += 256) sRpb[i] = p.in[20][h * 465 + i];
  const int qc = 16 * w + l15;
  int cs = qc - 8; cs = cs < 0 ? 0 : (cs > 48 ? 48 : cs);
  float m_run = -1e30f, l_run = 0.f;
  f32x4 o[4];
#pragma unroll
  for (int mt = 0; mt < 4; ++mt) o[mt] = f32x4{0.f, 0.f, 0.f, 0.f};
  typedef unsigned v4u __attribute__((ext_vector_type(4)));
#define ATT_PTRS(TILE, KP, VP, VS) { \
    if (sample && (TILE) < 4) { KP = CKB + (size_t)(b * 256 + 64 * (TILE)) * 512 + h * 64; VP = CVT + (size_t)(b * 512 + h * 64) * 256 + 64 * (TILE); VS = 256; } \
    else if (sample) { const int kr_ = rs + (TILE) - 4; KP = KB + (size_t)(tok0 + kr_ * 64) * 512 + h * 64; VP = VT + (size_t)(h * 64) * NTOK + tok0 + kr_ * 64; VS = NTOK; } \
    else { KP = KB + (size_t)(tok0 + 64 * (TILE)) * 512 + h * 64; VP = VT + (size_t)(h * 64) * NTOK + tok0 + 64 * (TILE); VS = NTOK; } }
  v4u rk0, rk1, rv0, rv1;
  {
    const u16 *kptr, *vptr; int vstride;
    ATT_PTRS(0, kptr, vptr, vstride)
    rk0 = *(const v4u*)(kptr + (size_t)lrow * 512 + lseg * 8);
    rk1 = *(const v4u*)(kptr + (size_t)(lrow + 32) * 512 + lseg * 8);
    rv0 = *(const v4u*)(vptr + (size_t)lrow * vstride + lseg * 8);
    rv1 = *(const v4u*)(vptr + (size_t)(lrow + 32) * vstride + lseg * 8);
  }
  *(v4u*)(sK + lrow * 72 + lseg * 8) = rk0; *(v4u*)(sK + (lrow + 32) * 72 + lseg * 8) = rk1;
  *(v4u*)(sV + lrow * 72 + lseg * 8) = rv0; *(v4u*)(sV + (lrow + 32) * 72 + lseg * 8) = rv1;
  __syncthreads();
  bf16x8 bq[2];
#pragma unroll
  for (int ks = 0; ks < 2; ++ks) bq[ks] = *(const bf16x8*)(sQ + (16 * w + l15) * 72 + 32 * ks + 8 * g);
  for (int tile = 0; tile < ntiles; ++tile) {
    const int cur = tile & 1;
    const u16* cK = sK + cur * (2 * 64 * 72);
    const u16* cV = sV + cur * (2 * 64 * 72);
    const bool local = sample && tile >= 4;
    const int dr = local ? (rs + tile - 4) - r + 7 : 0;
    {
      const int tn = tile + 1 < ntiles ? tile + 1 : tile;
      const u16 *kptr, *vptr; int vstride;
      ATT_PTRS(tn, kptr, vptr, vstride)
      rk0 = *(const v4u*)(kptr + (size_t)lrow * 512 + lseg * 8);
      rk1 = *(const v4u*)(kptr + (size_t)(lrow + 32) * 512 + lseg * 8);
      rv0 = *(const v4u*)(vptr + (size_t)lrow * vstride + lseg * 8);
      rv1 = *(const v4u*)(vptr + (size_t)(lrow + 32) * vstride + lseg * 8);
    }
    f32x4 s[4];
#pragma unroll
    for (int nt = 0; nt < 4; ++nt) {
      s[nt] = f32x4{0.f, 0.f, 0.f, 0.f};
#pragma unroll
      for (int ks = 0; ks < 2; ++ks) {
        const bf16x8 a = *(const bf16x8*)(cK + (16 * nt + l15) * 72 + 32 * ks + 8 * g);
        s[nt] = __builtin_amdgcn_mfma_f32_16x16x32_bf16(a, bq[ks], s[nt], 0, 0, 0);
      }
    }
    if (local) {
#pragma unroll
      for (int nt = 0; nt < 4; ++nt)
#pragma unroll
        for (int i = 0; i < 4; ++i) {
          const int kc = 16 * nt + 4 * g + i;
          const bool valid = kc >= cs && kc < cs + 16;
          int bi = kc - qc + 15; bi = bi < 0 ? 0 : (bi > 30 ? 30 : bi);
          s[nt][i] = valid ? s[nt][i] + sRpb[dr * 31 + bi] : -1e30f;
        }
    }
    float tmax = -1e30f;
#pragma unroll
    for (int nt = 0; nt < 4; ++nt)
#pragma unroll
      for (int i = 0; i < 4; ++i) tmax = fmaxf(tmax, s[nt][i]);
    tmax = fmaxf(tmax, __shfl_xor(tmax, 16));
    tmax = fmaxf(tmax, __shfl_xor(tmax, 32));
    const float m_new = fmaxf(m_run, tmax);
    const float alpha = __expf(m_run - m_new);
    m_run = m_new;
    float ps = 0.f;
#pragma unroll
    for (int nt = 0; nt < 4; ++nt)
#pragma unroll
      for (int i = 0; i < 4; ++i) { s[nt][i] = __expf(s[nt][i] - m_new); ps += s[nt][i]; }
    l_run = l_run * alpha + ps;
#pragma unroll
    for (int mt = 0; mt < 4; ++mt)
#pragma unroll
      for (int i = 0; i < 4; ++i) o[mt][i] *= alpha;
#pragma unroll
    for (int s2 = 0; s2 < 2; ++s2) {
      union { bf16x8 v; unsigned u[4]; } bp;
      bp.u[0] = pack2(s[2 * s2][0], s[2 * s2][1]);
      bp.u[1] = pack2(s[2 * s2][2], s[2 * s2][3]);
      bp.u[2] = pack2(s[2 * s2 + 1][0], s[2 * s2 + 1][1]);
      bp.u[3] = pack2(s[2 * s2 + 1][2], s[2 * s2 + 1][3]);
#pragma unroll
      for (int mt = 0; mt < 4; ++mt) {
        union { bf16x8 v; uint2 u[2]; } av;
        av.u[0] = *(const uint2*)(cV + (16 * mt + l15) * 72 + 32 * s2 + 4 * g);
        av.u[1] = *(const uint2*)(cV + (16 * mt + l15) * 72 + 32 * s2 + 16 + 4 * g);
        o[mt] = __builtin_amdgcn_mfma_f32_16x16x32_bf16(av.v, bp.v, o[mt], 0, 0, 0);
      }
    }
    {
      u16* nK = sK + (cur ^ 1) * (2 * 64 * 72);
      u16* nV = sV + (cur ^ 1) * (2 * 64 * 72);
      *(v4u*)(nK + lrow * 72 + lseg * 8) = rk0; *(v4u*)(nK + (lrow + 32) * 72 + lseg * 8) = rk1;
      *(v4u*)(nV + lrow * 72 + lseg * 8) = rv0; *(v4u*)(nV + (lrow + 32) * 72 + lseg * 8) = rv1;
    }
    __syncthreads();
  }
#undef ATT_PTRS
  l_run += __shfl_xor(l_run, 16);
  l_run += __shfl_xor(l_run, 32);
  const float inv = 1.f / l_run;
#pragma unroll
  for (int mt = 0; mt < 4; ++mt) {
    uint2 pk;
    pk.x = pack2(o[mt][0] * inv, o[mt][1] * inv);
    pk.y = pack2(o[mt][2] * inv, o[mt][3] * inv);
    *(uint2*)(MIX + (size_t)(tokq0 + qc) * DM + h * 64 + 16 * mt + 4 * g) = pk;
  }
}

__device__ __forceinline__ void lru1_item(int item, const Params& p, char* smem) {
  const int tid = TID(), lane = tid & 63, wid = tid >> 6;
  const int ch = item >> 3, blk = item & 7;
  u16* sXc = (u16*)smem;
  float* sXf = (float*)(smem + 9216);
  u16* sW = (u16*)(smem + 9216 + 16384);
  float* sA = (float*)(smem + 9216 + 16384 + 18432);
  float* sU = sA + 4096;
  float* sSegA = sU + 4096;
  float* sSegH = sSegA + 256;
  const float* XB = (const float*)(p.ws + WS_XB);
  float* HL = (float*)(p.ws + WS_HL);
  float* AC = (float*)(p.ws + WS_Z);
  float* AGA = (float*)(p.ws + WS_AGGA);
  float* AGH = (float*)(p.ws + WS_AGGH);
  const int tokc = ch * 64;
  int T, t0;
  if (ch < 64) { T = 256; t0 = (ch & 3) * 64; } else { T = 1024; t0 = ((ch - 64) & 15) * 64; }
  const int seq0 = tokc - t0;
  {
    const int c = tid & 63, tq = tid >> 6, cg_ = blk * 64 + c;
    float xv[19];
#pragma unroll
    for (int i = 0; i < 19; ++i) {
      const int t = t0 + tq * 16 + i - 1;
      xv[i] = (t >= 0 && t < T) ? __builtin_nontemporal_load(&XB[(size_t)(seq0 + t) * 512 + cg_]) : 0.f;
    }
    const float w0 = p.in[21][cg_], w1 = p.in[21][512 + cg_], w2 = p.in[21][1024 + cg_], w3 = p.in[21][1536 + cg_];
    const float cb = p.in[22][cg_];
#pragma unroll
    for (int i = 0; i < 16; ++i) {
      const float xc = cb + w0 * xv[i] + w1 * xv[i + 1] + w2 * xv[i + 2] + w3 * xv[i + 3];
      sXf[(tq * 16 + i) * 64 + c] = xc;
      sXc[(tq * 16 + i) * 72 + c] = f2bf(xc);
    }
  }
  const int wr = wid >> 1, wc = wid & 1, l31 = lane & 31, lh = lane >> 5;
  typedef unsigned v4u_t __attribute__((ext_vector_type(4)));
  v4u_t wreg[2][4];
#pragma unroll
  for (int d = 0; d < 2; ++d) {
    const u16* wsrc = (const u16*)(p.ws + WS_LRUW) + (size_t)((d * 8 + blk) * 2) * 4096;
#pragma unroll
    for (int i = 0; i < 4; ++i) {
      const int idx = tid + 256 * i;
      wreg[d][i] = *(const v4u_t*)(wsrc + (idx >> 3) * 64 + (idx & 7) * 8);
    }
  }
  float pbr[2], pbi[2], plam[2];
  {
    const int cg2 = blk * 64 + 32 * wc + l31;
#pragma unroll
    for (int d = 0; d < 2; ++d) { pbr[d] = p.in[24][d * 512 + cg2]; pbi[d] = p.in[26][d * 512 + cg2]; plam[d] = p.in[27][d * 512 + cg2]; }
  }
#pragma unroll
  for (int dir = 0; dir < 2; ++dir) {
    {
#pragma unroll
      for (int i = 0; i < 4; ++i) {
        const int idx = tid + 256 * i;
        const int row = idx >> 3, seg = idx & 7;
        *(v4u_t*)(sW + row * 72 + seg * 8) = wreg[dir][i];
      }
    }
    __syncthreads();
    f32x16 aR, aI;
#pragma unroll
    for (int r = 0; r < 16; ++r) { aR[r] = 0.f; aI[r] = 0.f; }
#pragma unroll
    for (int ks = 0; ks < 4; ++ks) {
      const bf16x8 a = *(const bf16x8*)(sXc + (32 * wr + l31) * 72 + 16 * ks + 8 * lh);
      const bf16x8 br = *(const bf16x8*)(sW + (32 * wc + l31) * 72 + 16 * ks + 8 * lh);
      const bf16x8 bi = *(const bf16x8*)(sW + (64 + 32 * wc + l31) * 72 + 16 * ks + 8 * lh);
      aR = __builtin_amdgcn_mfma_f32_32x32x16_bf16(a, br, aR, 0, 0, 0);
      aI = __builtin_amdgcn_mfma_f32_32x32x16_bf16(a, bi, aI, 0, 0, 0);
    }
    {
      const int c = 32 * wc + l31, cg_ = blk * 64 + c;
      const float br_ = pbr[dir], bi_ = pbi[dir];
      const float lam = plam[dir];
      const float ls = -log1pf(expf(-lam));
#pragma unroll
      for (int r = 0; r < 16; ++r) {
        const int t = 32 * wr + (r & 3) + 8 * (r >> 2) + 4 * lh;
        const float rg = 1.f / (1.f + __expf(-(aR[r] + br_)));
        const float ig = 1.f / (1.f + __expf(-(aI[r] + bi_)));
        const float la = 8.f * rg * ls;
        float em = la * (1.f + la * (0.5f + la * (0.16666667f + la * (0.041666668f + la * (0.0083333338f + la * 0.0013888889f)))));
        if (la < -0.3f) em = expm1f(la);
        const float a = 1.f + em;
        const float u = sqrtf(-em * (2.f + em)) * (ig * sXf[t * 64 + c]);
        sA[t * 64 + c] = a;
        sU[t * 64 + c] = u;
      }
    }
    __syncthreads();
    {
      const int c = tid & 63, seg = tid >> 6, cg_ = blk * 64 + c;
      float hh = 0.f, AA = 1.f;
#pragma unroll
      for (int i = 0; i < 16; ++i) {
        const int n = seg * 16 + i;
        const int t = dir ? 63 - n : n;
        const float a = sA[t * 64 + c], u = sU[t * 64 + c];
        hh = a * hh + u; AA *= a;
        sU[t * 64 + c] = hh; sA[t * 64 + c] = AA;
      }
      sSegA[seg * 64 + c] = AA; sSegH[seg * 64 + c] = hh;
      __syncthreads();
      float cin = 0.f, P = 1.f;
#pragma unroll
      for (int s2 = 0; s2 < 3; ++s2) {
        if (s2 < seg) { const float a = sSegA[s2 * 64 + c]; cin = a * cin + sSegH[s2 * 64 + c]; P *= a; }
      }
      float hl_last = 0.f;
#pragma unroll
      for (int i = 0; i < 16; ++i) {
        const int n = seg * 16 + i;
        const int t = dir ? 63 - n : n;
        const float acs = sA[t * 64 + c];
        const float hl = sU[t * 64 + c] + acs * cin;
        const size_t gi = ((size_t)dir * NTOK + tokc + t) * 512 + cg_;
        __builtin_nontemporal_store(hl, &HL[gi]); __builtin_nontemporal_store(acs * P, &AC[gi]);
        hl_last = hl;
      }
      if (seg == 3) {
        AGA[(dir * 96 + ch) * 512 + cg_] = sSegA[3 * 64 + c] * P;
        AGH[(dir * 96 + ch) * 512 + cg_] = hl_last;
      }
    }
    __syncthreads();
  }
}

__device__ __forceinline__ void lru2_item(int item, const Params& p) {
  const int tid = TID();
  const int ch = item >> 4, qd = (item >> 2) & 3, tq = item & 3;
  const int c = qd * 128 + (tid & 127), th = tid >> 7;
  const float* HL = (const float*)(p.ws + WS_HL);
  const float* AC = (const float*)(p.ws + WS_Z);
  const float* AGA = (const float*)(p.ws + WS_AGGA);
  const float* AGH = (const float*)(p.ws + WS_AGGH);
  const u16* GG = (const u16*)(p.ws + WS_GG);
  u16* MIX = (u16*)(p.ws + WS_MIX);
  int first, nch; float cf, cb;
  if (ch < 64) { first = ch & ~3; nch = 4; cf = 0.f; cb = 0.f; }
  else { const int b = (ch - 64) >> 4; first = 64 + b * 16; nch = 16; cf = p.in[4][b * 512 + c]; cb = p.in[5][b * 512 + c]; }
  const int last = first + nch - 1;
  const int tokc = ch * 64, tb = tq * 16 + th * 8;
  float hl0[8], ac0[8], hl1[8], ac1[8], gg[8];
#pragma unroll
  for (int i = 0; i < 8; ++i) {
    const size_t g0 = ((size_t)tokc + tb + i) * 512 + c;
    const size_t g1 = g0 + (size_t)NTOK * 512;
    hl0[i] = __builtin_nontemporal_load(&HL[g0]); ac0[i] = __builtin_nontemporal_load(&AC[g0]);
    hl1[i] = __builtin_nontemporal_load(&HL[g1]); ac1[i] = __builtin_nontemporal_load(&AC[g1]); gg[i] = bf2f(GG[g0]);
  }
#pragma unroll
  for (int j = 0; j < 16; ++j) {
    int idx = first + j; const bool valid = idx < ch; idx = valid ? idx : first;
    const float a = AGA[(0 * 96 + idx) * 512 + c], hh = AGH[(0 * 96 + idx) * 512 + c];
    cf = valid ? a * cf + hh : cf;
  }
#pragma unroll
  for (int j = 0; j < 16; ++j) {
    int idx = last - j; const bool valid = idx > ch; idx = valid ? idx : last;
    const float a = AGA[(1 * 96 + idx) * 512 + c], hh = AGH[(1 * 96 + idx) * 512 + c];
    cb = valid ? a * cb + hh : cb;
  }
#pragma unroll
  for (int i = 0; i < 8; ++i) {
    const int t = tb + i;
    const float hf = hl0[i] + ac0[i] * cf;
    const float hb = hl1[i] + ac1[i] * cb;
    MIX[((size_t)tokc + t) * DM + 512 + c] = f2bf((hf + hb) * gg[i]);
    if (ch < 64) {
      if (t == 63 && (ch & 3) == 3) p.out[10485760 + (ch >> 2) * 512 + c] = hf;
      if (t == 0 && (ch & 3) == 0) p.out[10493952 + (ch >> 2) * 512 + c] = hb;
    }
  }
}

#define XB_TMO      128
#define XB_XCNT(j)  (256  + 64 * (j))
#define XB_XSUB(j)  (1280 + 64 * (j))
#define XB_XGEN(j)  (2304 + 64 * (j))
#define XB_TOP      3328
#define XB_TOPGEN   3392
#define XCD_BAR_WORDS 3456
#define XB_SPIN_CAP (1u << 18)
#define LAS __attribute__((address_space(3)))
__device__ __forceinline__ unsigned xb_ld(unsigned* p) { return __hip_atomic_load(p, __ATOMIC_RELAXED, __HIP_MEMORY_SCOPE_AGENT); }
__device__ __forceinline__ unsigned xb_add(unsigned* p, unsigned v) { return __hip_atomic_fetch_add(p, v, __ATOMIC_RELAXED, __HIP_MEMORY_SCOPE_AGENT); }
__device__ __forceinline__ unsigned xb_xcc_id() { return (unsigned)__builtin_amdgcn_s_getreg((3 << 11) | 20) & 0xFu; }
#define XB_SPIN(cond, bar) do { unsigned _sp = 0; while (cond) { __builtin_amdgcn_s_sleep(1); \
    if ((++_sp & 255u) == 0u) { if (xb_ld(&(bar)[XB_TMO])) break; if (_sp > XB_SPIN_CAP) { atomicAdd(&(bar)[XB_TMO], 1u); break; } } } } while (0)
struct XcdBarrier { unsigned* bar; unsigned x; volatile LAS unsigned* st; unsigned nloc, nx; };
__device__ __forceinline__ XcdBarrier xcd_barrier_post(unsigned* bar, volatile LAS unsigned* st) {
  XcdBarrier b; b.bar = bar; b.x = xb_xcc_id(); b.st = st; b.nloc = 0u; b.nx = 0u;
  if (threadIdx.x == 0) (void)xb_add(&bar[XB_XCNT(b.x)], 1u);
  return b;
}
__device__ __forceinline__ void xcd_barrier_complete(unsigned* bar, unsigned x, unsigned& nloc, unsigned& nx) {
  const unsigned G = gridDim.x * gridDim.y * gridDim.z;
  unsigned sum, cnt, mine, sp = 0u;
  for (;;) {
    sum = 0u; cnt = 0u; mine = 0u;
    unsigned cv[16];
#pragma unroll
    for (unsigned j = 0; j < 16; ++j) cv[j] = xb_ld(&bar[XB_XCNT(j)]);
    asm volatile("" ::: "memory"); __builtin_amdgcn_sched_barrier(0);
#pragma unroll
    for (unsigned j = 0; j < 16; ++j) { const unsigned c = cv[j]; sum += c; cnt += (c > 0u) ? 1u : 0u; mine = (j == x) ? c : mine; }
    if (sum == G) break;
    __builtin_amdgcn_s_sleep(1);
    if ((++sp & 255u) == 0u) { if (xb_ld(&bar[XB_TMO])) break; if (sp > XB_SPIN_CAP) { atomicAdd(&bar[XB_TMO], 1u); break; } }
  }
  nloc = mine > 0u ? mine : 1u; nx = cnt > 0u ? cnt : 1u;
}
__device__ __forceinline__ void xcd_barrier(XcdBarrier& b, bool acquire) {
  asm volatile("s_waitcnt vmcnt(0)" ::: "memory");
  __syncthreads();
  if (threadIdx.x == 0) {
    unsigned* bar = b.bar;
    __builtin_amdgcn_s_waitcnt(0);
    unsigned nloc = b.nloc, nx = b.nx;
    if (nloc == 0u) { xcd_barrier_complete(bar, b.x, nloc, nx); b.st[0] = nloc; b.st[1] = nx; }
    const unsigned old = xb_add(&bar[XB_XSUB(b.x)], 1u);
    const unsigned gen = old / nloc;
    if (old + 1u == (gen + 1u) * nloc) {
      __builtin_amdgcn_fence(__ATOMIC_RELEASE, "agent");
      asm volatile("s_waitcnt vmcnt(0)" ::: "memory");
      const unsigned og = xb_add(&bar[XB_TOP], 1u);
      const unsigned tg = og / nx;
      if (og + 1u == (tg + 1u) * nx) xb_add(&bar[XB_TOPGEN], 1u);
      else XB_SPIN(xb_ld(&bar[XB_TOPGEN]) == tg, bar);
      if (acquire) __builtin_amdgcn_fence(__ATOMIC_ACQUIRE, "agent");
      xb_add(&bar[XB_XGEN(b.x)], 1u);
      asm volatile("s_waitcnt vmcnt(0)" ::: "memory");
    } else {
      XB_SPIN(xb_ld(&bar[XB_XGEN(b.x)]) == gen, bar);
      if (acquire) __builtin_amdgcn_fence(__ATOMIC_ACQUIRE, "agent");
      asm volatile("s_waitcnt vmcnt(0)" ::: "memory");
    }
  }
  __syncthreads();
  if (b.nloc == 0u) { b.nloc = b.st[0]; b.nx = b.st[1]; }
}

enum { K_PREP, K_NORM0, K_GU1, K_DOWN1, K_NORM1, K_INPROJ, K_ATTLRU, K_LRU2, K_OUTAB, K_NORM2, K_GU2, K_DOWN2, K_NORMT, K_DFTT, K_DFTC, K_OUTC };
#define PHASE_FN __device__ __forceinline__

PHASE_FN void ph_prep(const Params& p, char* smem) { phase_prep(p, smem); }

PHASE_FN void ph_norm(const Params& p, int l, int kind, char* smem) {
  float* X = (float*)(p.ws + WS_X);
  const bool first = (l == 0 && kind == K_NORM0);
  const float* x0 = first ? p.in[0] : X;
  const float* x1 = first ? p.in[1] : X + (size_t)NCTX * DM;
  if (kind == K_NORMT) phase_normT(p, x0, x1, l, 1, smem);
  else phase_norm(p, x0, x1, l, kind == K_NORM0 ? 0 : kind == K_NORM1 ? 1 : 2);
}

PHASE_FN void ph_gu(const Params& p, int l, int f, char* smem) {
  EpiP e{}; e.outb = (u16*)(p.ws + (f ? WS_HL : WS_H));
  const u16* A = (const u16*)(p.ws + (((l * 3 + (f ? 2 : 0)) & 1) ? WS_HNB : WS_HN));
  const u16* Bt = (const u16*)(p.ws + WS_WGU) + (size_t)(l * 2 + f) * 5632 * 1024;
  for (int t = blockIdx.x; t < 32 * 44; t += gridDim.x)
    gemm_tile<EPI_SWIGLU, 2, 2, 3, 2>(A, 1024, Bt, 1024, 1024, (t % 32) * 192, (t / 32) * 128, e, smem);
  {
    const int nb = gridDim.x, extra = (32 * 44) % nb, b = blockIdx.x;
    TcPlan pl{{0, 0, 0, 0}, {0, 0, 0, 0}};
    if (l == 0 && f == 0) pl = TcPlan{{2816, 4224, 1088, 0}, {352, 320, 320, 0}};
    else if (l == 0 && f == 1) pl = TcPlan{{3168, 1408, 0, 0}, {352, 704, 0, 0}};
    else if (l == 1 && f == 0) pl = TcPlan{{3520, 4672, 2112, 0}, {352, 128, 704, 0}};
    else pl = TcPlan{{3872, 0, 0, 0}, {352, 0, 0, 0}};
    if (b >= extra) tc_run(p, smem, pl, b - extra, nb - extra);
  }
}

PHASE_FN void ph_resid(const Params& p, int l, int kind, int rep, char* smem) {
  float* X = (float*)(p.ws + WS_X);
  const bool first = (l == 0 && kind == K_DOWN1);
  const float* MOD = (const float*)(p.ws + WS_MOD) + (size_t)l * 3 * 9216;
  EpiP e{};
  const u16 *A, *Bt; int K, gi;
  if (kind == K_DOWN1 || kind == K_DOWN2) {
    const int f = kind == K_DOWN1 ? 0 : 1;
    A = (const u16*)(p.ws + (f ? WS_HL : WS_H)); K = DFF; Bt = (const u16*)(p.ws + WS_WD) + (size_t)(l * 2 + f) * 1024 * DFF;
    gi = f == 0 ? 2 : 8; e.gscale = 0.5f;
  } else if (kind == K_OUTAB) {
    A = (const u16*)(p.ws + WS_MIX); K = 1024; Bt = (const u16*)(p.ws + WS_WOAB); gi = 5; e.gscale = 1.f;
  } else {
    A = (const u16*)(p.ws + WS_F); K = 1024; Bt = (const u16*)(p.ws + WS_WOC); gi = 5; e.gscale = 1.f;
  }
  e.gate = MOD + gi * 1024;
  e.res0 = first ? p.in[0] : X;
  e.res1 = first ? p.in[1] : X + (size_t)NCTX * DM;
  e.outf = (l == 1 && kind == K_DOWN2) ? p.out : X;
  if (rep > 0) e.outf = (float*)(p.ws + WS_Z);
  for (int t = blockIdx.x; t < 64 * 8; t += gridDim.x)
    gemm_tile<EPI_RESID, 1, 4, 3, 1>(A, K, Bt, K, K, (t % 64) * 96, (t / 64) * 128, e, smem);
}

PHASE_FN void ph_inproj(const Params& p, char* smem) {
  EpiP e{};
  e.q = (u16*)(p.ws + WS_Q); e.k = (u16*)(p.ws + WS_K); e.vT = (u16*)(p.ws + WS_VT); e.gg = (u16*)(p.ws + WS_GG);
  e.xb = (float*)(p.ws + WS_XB); e.qg = p.in[18]; e.kg = p.in[19];
  e.outk = p.out + 6291456; e.outv = p.out + 8388608;
  const u16* A = (const u16*)(p.ws + WS_HNB);
  const u16* Bt = (const u16*)(p.ws + WS_WIN);
  for (int t = blockIdx.x; t < 48 * 20; t += gridDim.x)
    gemm_tile<EPI_INPROJ>(A, 1024, Bt, 1024, 1024, (t % 48) * 128, (t / 48) * 128, e, smem);
  {
    const int nb = gridDim.x, extra = (48 * 20) % nb, b = blockIdx.x;
    const TcPlan pl{{4544, 704, 0, 0}, {128, 384, 0, 0}};
    if (b >= extra) tc_run(p, smem, pl, b - extra, nb - extra);
  }
}

PHASE_FN void ph_attn(const Params& p, char* smem) {
  for (int t = blockIdx.x; t < 768; t += gridDim.x) { attn_item(t, p, smem); __syncthreads(); }
}
PHASE_FN void ph_lru1(const Params& p, char* smem) {
  const int nb = gridDim.x;
  for (int t = nb - 1 - (int)blockIdx.x; t < 768; t += nb) { lru1_item(t, p, smem); __syncthreads(); }
}
PHASE_FN void ph_lru2(const Params& p) {
  for (int t = blockIdx.x; t < 1536; t += gridDim.x) lru2_item(t, p);
}

PHASE_FN void ph_dftt(const Params& p, char* smem) {
  const u16* HNT = (const u16*)(p.ws + WS_HN);
  EpiP e{}; e.outb = (u16*)(p.ws + WS_Z2);
  const int nb = gridDim.x, b = blockIdx.x;
  for (int i = 0;; ++i) {
    int t;
    if (nb == 512) { if (b < 256) { if (i > 0) break; t = b; } else { if (i > 1) break; t = 256 + (b - 256) * 2 + i; } }
    else { t = b + i * nb; if (t >= 768) break; }
    const u16* A; int T, m0, n0;
    if (t < 256) { const int bb = t >> 7, r = t & 127; e.tok0 = NCTX + bb * 1024; T = 1024; A = (const u16*)(p.ws + WS_CT1024); m0 = (r & 15) * 128; n0 = (r >> 4) * 128; }
    else { const int t2 = t - 256, bb = t2 >> 5, r = t2 & 31; e.tok0 = bb * 256; T = 256; A = (const u16*)(p.ws + WS_CT256); m0 = (r & 3) * 128; n0 = (r >> 2) * 128; }
    e.T = T;
    gemm_tile<EPI_DFTT>(A, T, HNT + (size_t)e.tok0 * 1024, T, T, m0, n0, e, smem);
  }
}

PHASE_FN void ph_dftc(const Params& p, char* smem) {
  EpiP e{}; e.outb = (u16*)(p.ws + WS_F); e.ldc = 256;
  for (int t = blockIdx.x; t < 256 * 2; t += gridDim.x)
    gemm_tile<EPI_BF16, 1, 4, 3, 1>((const u16*)(p.ws + WS_Z2), 512, (const u16*)(p.ws + WS_CS2), 512, 512, (t >> 1) * 96, (t & 1) * 128, e, smem);
}

#ifndef REPMASK
#define REPMASK 0u
#define REPN 0
#endif
__device__ __forceinline__ int kind_of(int ph) {
  if (ph == 0) return K_PREP;
  if (ph <= 11) return ph;
  const int i = ph - 12;
  return i == 0 ? K_NORM0 : i == 1 ? K_GU1 : i == 2 ? K_DOWN1 : i == 3 ? K_NORMT : i == 4 ? K_DFTT : i == 5 ? K_DFTC :
         i == 6 ? K_OUTC : i == 7 ? K_NORM2 : i == 8 ? K_GU2 : K_DOWN2;
}
__device__ __forceinline__ void run_phase(int ph, int rep, const Params& p, char* smem) {
  int kind, l;
  if (ph == 0) { kind = K_PREP; l = 0; }
  else if (ph <= 11) { l = 0; kind = ph; }
  else {
    l = 1;
    const int i = ph - 12;
    kind = i == 0 ? K_NORM0 : i == 1 ? K_GU1 : i == 2 ? K_DOWN1 : i == 3 ? K_NORMT : i == 4 ? K_DFTT : i == 5 ? K_DFTC :
           i == 6 ? K_OUTC : i == 7 ? K_NORM2 : i == 8 ? K_GU2 : K_DOWN2;
  }
  switch (kind) {
    case K_PREP: ph_prep(p, smem); break;
    case K_NORM0: case K_NORM1: case K_NORM2: case K_NORMT: ph_norm(p, l, kind, smem); break;
    case K_GU1: ph_gu(p, l, 0, smem); break;
    case K_GU2: ph_gu(p, l, 1, smem); break;
    case K_DOWN1: case K_DOWN2: case K_OUTAB: case K_OUTC: ph_resid(p, l, kind, rep, smem); break;
    case K_INPROJ: ph_inproj(p, smem); break;
    case K_ATTLRU: ph_attn(p, smem); ph_lru1(p, smem); break;
    case K_LRU2: ph_lru2(p); break;
    case K_DFTT: ph_dftt(p, smem); break;
    case K_DFTC: ph_dftc(p, smem); break;
  }
}

__global__ void __launch_bounds__(256, 2) mega(Params p_) {
  __shared__ __attribute__((aligned(16))) char smem[SMEM_BYTES + 16];
  cg::grid_group grid = cg::this_grid();
  const int ph_lo = p_.ph_lo, ph_hi = p_.ph_hi, coop = p_.coop;
  volatile LAS unsigned* st = (volatile LAS unsigned*)(smem + SMEM_BYTES);
  if (threadIdx.x == 0) { st[0] = 0u; st[1] = 0u; st[2] = 0u; st[3] = 0u; }
  __syncthreads();
  XcdBarrier xb = xcd_barrier_post((unsigned*)(p_.ws + WS_BAR), st);
  for (int ph = ph_lo; ph < ph_hi; ++ph) {
    auto ka = __builtin_amdgcn_kernarg_segment_ptr();
    asm volatile("" : "+s"(ka));
    const Params& p = *(const Params*)ka;
    const int nrep = ((REPMASK >> kind_of(ph)) & 1u) ? 1 + REPN : 1;
    for (int rep = nrep - 1; rep >= 0; --rep) {
      run_phase(ph, rep, p, smem);
      if (ph + 1 < ph_hi || rep > 0) {
        const bool need_acq = (ph == 8 || ph == 11 || ph == 14 || ph == 18) || rep > 0;
        if (coop == 1) xcd_barrier(xb, need_acq);
        else if (coop == 2) grid.sync();
      }
    }
  }
}

extern "C" void kernel_launch(void* const* d_in, const int* in_sizes, int n_in, void* d_out, int out_size, void* d_ws,
                              size_t ws_size, hipStream_t stream) {
  static int grid_blocks = 0;
  if (!grid_blocks) {
    int dev = 0, cus = 0, per_cu = 0;
    hipGetDevice(&dev);
    hipDeviceGetAttribute(&cus, hipDeviceAttributeMultiprocessorCount, dev);
    hipOccupancyMaxActiveBlocksPerMultiprocessor(&per_cu, mega, 256, 0);
    if (per_cu > 2) per_cu = 2;
    if (per_cu < 1) per_cu = 1;
    grid_blocks = cus * per_cu;
    if (ws_size < WS_END) fprintf(stderr, "workspace too small: %zu < %zu\n", ws_size, (size_t)WS_END);
  }
  Params p{};
  for (int i = 0; i < 30; ++i) p.in[i] = (const float*)d_in[i];
  p.out = (float*)d_out;
  p.ws = (char*)d_ws;
#if ONE_LAUNCH
  p.ph_lo = 0; p.ph_hi = NPH; p.coop = 1;
  hipMemsetAsync((char*)d_ws + WS_BAR, 0, XCD_BAR_WORDS * 4, stream);
  void* args[] = {&p};
  hipError_t e = hipLaunchCooperativeKernel((void*)mega, dim3(grid_blocks), dim3(256), args, 0, stream);
  if (e != hipSuccess) fprintf(stderr, "cooperative launch failed: %s (grid %d)\n", hipGetErrorString(e), grid_blocks);
#else
  for (int ph = 0; ph < NPH; ++ph) {
    p.ph_lo = ph; p.ph_hi = ph + 1; p.coop = 0;
    hipLaunchKernelGGL(mega, dim3(grid_blocks), dim3(256), 0, stream, p);
  }
#endif
}
```

```cpp
#include <hip/hip_runtime.h>
#include <hip/hip_cooperative_groups.h>
#include <cstdio>
namespace cg = cooperative_groups;

typedef unsigned short u16;
using bf16x8 = __attribute__((ext_vector_type(8))) short;
using bf16x4 = __attribute__((ext_vector_type(4))) short;
using f32x16 = __attribute__((ext_vector_type(16))) float;
using f32x4 = __attribute__((ext_vector_type(4))) float;

#ifndef ONE_LAUNCH
#define ONE_LAUNCH 1
#endif

constexpr int NTOK = 6144, NCTX = 4096, DM = 1024, DFF = 2816;
constexpr int NPH = 22;

constexpr size_t WS_MOD = 0;
constexpr size_t WS_WGU = WS_MOD + 221184;
constexpr size_t WS_WD = WS_WGU + 4ull * 5632 * 1024 * 2;
constexpr size_t WS_WIN = WS_WD + 4ull * 1024 * 2816 * 2;
constexpr size_t WS_WOAB = WS_WIN + 2560ull * 1024 * 2;
constexpr size_t WS_WOC = WS_WOAB + 1024ull * 1024 * 2;
constexpr size_t WS_CKB = WS_WOC + 1024ull * 1024 * 2;
constexpr size_t WS_CVT = WS_CKB + 524288;
constexpr size_t WS_LRUW = WS_CVT + 524288;
constexpr size_t WS_CT256 = WS_LRUW + 262144;
constexpr size_t WS_CT1024 = WS_CT256 + 262144;
constexpr size_t WS_CS2 = WS_CT1024 + 4194304;
constexpr size_t WS_X = WS_CS2 + 262144;
constexpr size_t WS_HN = WS_X + 6144ull * 1024 * 4;
constexpr size_t WS_H = WS_HN + 6144ull * 1024 * 2;
constexpr size_t WS_Q = WS_H + 6144ull * 2816 * 2;
constexpr size_t WS_K = WS_Q + 6144ull * 512 * 2;
constexpr size_t WS_VT = WS_K + 6144ull * 512 * 2;
constexpr size_t WS_XB = WS_VT + 6144ull * 512 * 2;
constexpr size_t WS_GG = WS_XB + 6144ull * 512 * 4;
constexpr size_t WS_MIX = WS_GG + 6144ull * 512 * 2;
constexpr size_t WS_Z = WS_MIX + 6144ull * 1024 * 2;
constexpr size_t WS_AGGA = WS_Z + 6144ull * 2048 * 2;
constexpr size_t WS_AGGH = WS_AGGA + 393216;
constexpr size_t WS_BAR = WS_AGGH + 393216;
constexpr size_t WS_HL = WS_BAR + 16384;
constexpr size_t WS_Z2 = WS_HL + 2ull * 6144 * 512 * 4;
constexpr size_t WS_F = WS_Z;
constexpr size_t WS_HNB = WS_Z2 + 6144ull * 2048 * 2;
constexpr size_t WS_END = WS_HNB + 6144ull * 1024 * 2;

constexpr int SMEM_BYTES = 81920 - 16;

struct Params {
  const float* in[30];
  float* out;
  char* ws;
  int ph_lo, ph_hi, coop, pad;
};

struct EpiP {
  float* outf; u16* outb; int ldc; int tok0;
  const float* res0; const float* res1;
  const float* gate; float gscale; int T;
  u16 *q, *k, *vT, *gg; float* xb;
  const float *qg, *kg; float *outk, *outv;
};

__device__ __forceinline__ u16 f2bf(float f) {
  unsigned u = __float_as_uint(f);
  u += 0x7fffu + ((u >> 16) & 1u);
  return (u16)(u >> 16);
}
__device__ __forceinline__ unsigned pack2(float a, float b) { return (unsigned)f2bf(a) | ((unsigned)f2bf(b) << 16); }
__device__ __forceinline__ float bf2f(u16 v) { return __uint_as_float(((unsigned)v) << 16); }
__device__ __forceinline__ float sigmoidf_(float x) { return 1.f / (1.f + __expf(-x)); }
__device__ __forceinline__ int cond_of(int row) { return row < NCTX ? 0 : 1 + ((row - NCTX) >> 10); }

__device__ __forceinline__ int TID() { int t = __builtin_amdgcn_workitem_id_x(); asm volatile("" : "+v"(t)); return t; }

__device__ __forceinline__ void st_wt(u16* p, u16 v) { __hip_atomic_store(p, v, __ATOMIC_RELAXED, __HIP_MEMORY_SCOPE_AGENT); }
__device__ __forceinline__ void st_wt(float* p, float v) { *p = v; }
__device__ __forceinline__ void st_wt(uint2* p, uint2 v) {
  unsigned long long w = (unsigned long long)v.x | ((unsigned long long)v.y << 32);
  __hip_atomic_store((unsigned long long*)p, w, __ATOMIC_RELAXED, __HIP_MEMORY_SCOPE_AGENT);
}

enum { EPI_SWIGLU = 0, EPI_RESID = 1, EPI_INPROJ = 2, EPI_DFTT = 3, EPI_BF16 = 4 };

template <int EPI, int WR = 2, int WC = 2, int MI = 2, int NI = 2>
__device__ __forceinline__ void gemm_tile(const u16* __restrict__ A, int lda, const u16* __restrict__ Bt, int ldb,
                                          int K, int m0, int n0, const EpiP& e, char* smem) {
  constexpr int TM = WR * MI * 32, TN = WC * NI * 32, NA = TM / 32, NB = TN / 32;
  static_assert(WR * WC == 4, "4 waves");
  static_assert(EPI == EPI_RESID || EPI == EPI_BF16 || (WR == 2 && WC == 2 && NI == 2 && (MI == 2 || EPI == EPI_SWIGLU)), "tile config not supported by this epilogue");
  typedef unsigned v4u __attribute__((ext_vector_type(4)));
  const int tid = TID(), lane = tid & 63, wid = tid >> 6, wr = wid / WC, wc = wid % WC;
  u16* sA = (u16*)smem;
  u16* sB = sA + 2 * TM * 72;
  f32x16 acc[MI][NI];
#pragma unroll
  for (int i = 0; i < MI; ++i)
#pragma unroll
    for (int j = 0; j < NI; ++j)
#pragma unroll
      for (int r = 0; r < 16; ++r) acc[i][j][r] = 0.f;
  typedef __attribute__((address_space(3))) void* lds_ptr_t;
  const int lr8 = lane >> 3, lp = lane & 7;
  const int nk = K >> 6;
  const u16* gA[NA]; const u16* gB[NB];
#pragma unroll
  for (int j = 0; j < NA; ++j) { const int r = 8 * (j * 4 + wid) + lr8; gA[j] = A + (size_t)(m0 + r) * lda + ((lp ^ ((r >> 1) & 7)) << 3); }
#pragma unroll
  for (int j = 0; j < NB; ++j) { const int r = 8 * (j * 4 + wid) + lr8; gB[j] = Bt + (size_t)(n0 + r) * ldb + ((lp ^ ((r >> 1) & 7)) << 3); }
  char* const sAl = smem + wid * 1024 + lane * 16;
  char* const sBl = smem + 2 * TM * 128 + wid * 1024 + lane * 16;
#define G_ISSUE(BUF, KO) { \
    _Pragma("unroll") for (int j = 0; j < NA; ++j) __builtin_amdgcn_global_load_lds((const void*)(gA[j] + (KO)), (lds_ptr_t)(sAl + (BUF) * TM * 128 + j * 4096), 16, 0, 0); \
    _Pragma("unroll") for (int j = 0; j < NB; ++j) __builtin_amdgcn_global_load_lds((const void*)(gB[j] + (KO)), (lds_ptr_t)(sBl + (BUF) * TN * 128 + j * 4096), 16, 0, 0); }
  const int fsw = ((lane & 31) >> 1) & 7;
#define G_COMPUTE(BUF) { \
    const char* a_base = smem + (BUF) * TM * 128 + (wr * MI * 32 + (lane & 31)) * 128; \
    const char* b_base = smem + 2 * TM * 128 + (BUF) * TN * 128 + (wc * NI * 32 + (lane & 31)) * 128; \
    _Pragma("unroll") for (int ks = 0; ks < 4; ++ks) { \
      const int co = ((ks * 2 + (lane >> 5)) ^ fsw) << 4; \
      bf16x8 af[MI], bfr[NI]; \
      _Pragma("unroll") for (int mi = 0; mi < MI; ++mi) af[mi] = *(const bf16x8*)(a_base + mi * 32 * 128 + co); \
      _Pragma("unroll") for (int ni = 0; ni < NI; ++ni) bfr[ni] = *(const bf16x8*)(b_base + ni * 32 * 128 + co); \
      _Pragma("unroll") for (int mi = 0; mi < MI; ++mi) \
        _Pragma("unroll") for (int ni = 0; ni < NI; ++ni) \
          acc[mi][ni] = __builtin_amdgcn_mfma_f32_32x32x16_bf16(af[mi], bfr[ni], acc[mi][ni], 0, 0, 0); } }
  G_ISSUE(0, 0)
  asm volatile("s_waitcnt vmcnt(0)" ::: "memory");
  __syncthreads();
  for (int kt = 0; kt < nk; kt += 2) {
    G_ISSUE(1, (kt + 1) * 64)
    G_COMPUTE(0)
    asm volatile("s_waitcnt vmcnt(0)" ::: "memory");
    __syncthreads();
    if (kt + 2 < nk) { G_ISSUE(0, (kt + 2) * 64) }
    G_COMPUTE(1)
    asm volatile("s_waitcnt vmcnt(0)" ::: "memory");
    __syncthreads();
  }
#undef G_ISSUE
#undef G_COMPUTE
  const int l31 = lane & 31, lh = lane >> 5;
  if constexpr (EPI == EPI_SWIGLU) {
    const int colh = (n0 >> 1) + wc * 32 + l31;
#pragma unroll
    for (int mi = 0; mi < MI; ++mi)
#pragma unroll
      for (int r = 0; r < 16; ++r) {
        const int row = m0 + wr * (MI * 32) + mi * 32 + (r & 3) + 8 * (r >> 2) + 4 * lh;
        const float g = acc[mi][0][r], u = acc[mi][1][r];
        e.outb[(size_t)row * DFF + colh] = f2bf(g * sigmoidf_(g) * u);
      }
  } else if constexpr (EPI == EPI_RESID) {
    const float* res1m = e.res1 - (size_t)NCTX * DM;
    float g3[NI][3];
#pragma unroll
    for (int ni = 0; ni < NI; ++ni)
#pragma unroll
      for (int c = 0; c < 3; ++c) g3[ni][c] = e.gscale * e.gate[c * 9216 + n0 + wc * (NI * 32) + ni * 32 + l31];
    float rv[MI][NI][16];
#pragma unroll
    for (int mi = 0; mi < MI; ++mi)
#pragma unroll
      for (int r = 0; r < 16; ++r) {
        const int row = m0 + wr * (MI * 32) + mi * 32 + (r & 3) + 8 * (r >> 2) + 4 * lh;
        const float* rp = (row < NCTX ? e.res0 : res1m) + (size_t)row * DM;
#pragma unroll
        for (int ni = 0; ni < NI; ++ni) rv[mi][ni][r] = rp[n0 + wc * (NI * 32) + ni * 32 + l31];
      }
    asm volatile("" ::: "memory"); __builtin_amdgcn_sched_barrier(0);
#pragma unroll
    for (int mi = 0; mi < MI; ++mi)
#pragma unroll
      for (int r = 0; r < 16; ++r) {
        const int row = m0 + wr * (MI * 32) + mi * 32 + (r & 3) + 8 * (r >> 2) + 4 * lh;
        const int c = cond_of(row);
#pragma unroll
        for (int ni = 0; ni < NI; ++ni) {
          const int col = n0 + wc * (NI * 32) + ni * 32 + l31;
          const float gg_ = c == 0 ? g3[ni][0] : (c == 1 ? g3[ni][1] : g3[ni][2]);
          st_wt(&e.outf[(size_t)row * DM + col], rv[mi][ni][r] + gg_ * acc[mi][ni][r]);
        }
      }
  } else if constexpr (EPI == EPI_INPROJ) {
    const int sec = n0 >> 9;
    const int cb = (n0 & 511) + wc * 64;
    if (sec <= 1) {
      const float* gv = sec == 0 ? e.qg : e.kg;
      const float g0 = gv[l31], g1 = gv[32 + l31];
      const float sc = sec == 0 ? 0.125f : 1.f;
#pragma unroll
      for (int mi = 0; mi < 2; ++mi)
#pragma unroll
        for (int r = 0; r < 16; ++r) {
          const int row = m0 + wr * 64 + mi * 32 + (r & 3) + 8 * (r >> 2) + 4 * lh;
          const float v0 = acc[mi][0][r], v1 = acc[mi][1][r];
          float ss = v0 * v0 + v1 * v1;
          ss += __shfl_xor(ss, 1); ss += __shfl_xor(ss, 2); ss += __shfl_xor(ss, 4);
          ss += __shfl_xor(ss, 8); ss += __shfl_xor(ss, 16);
          const float rs = rsqrtf(ss * (1.f / 64.f) + 1e-6f) * sc;
          const float o0 = v0 * rs * g0, o1 = v1 * rs * g1;
          u16* dst = (sec == 0 ? e.q : e.k) + (size_t)row * 512 + cb;
          dst[l31] = f2bf(o0); dst[32 + l31] = f2bf(o1);
          if (sec == 1 && row < NCTX) {
            __builtin_nontemporal_store(o0, &e.outk[(size_t)row * 512 + cb + l31]);
            __builtin_nontemporal_store(o1, &e.outk[(size_t)row * 512 + cb + 32 + l31]);
          }
        }
    } else if (sec == 2) {
#pragma unroll
      for (int mi = 0; mi < 2; ++mi)
#pragma unroll
        for (int ni = 0; ni < 2; ++ni) {
          const int col = cb + ni * 32 + l31;
#pragma unroll
          for (int q4 = 0; q4 < 4; ++q4) {
            const int row = m0 + wr * 64 + mi * 32 + 8 * q4 + 4 * lh;
            uint2 pk;
            pk.x = pack2(acc[mi][ni][4 * q4 + 0], acc[mi][ni][4 * q4 + 1]);
            pk.y = pack2(acc[mi][ni][4 * q4 + 2], acc[mi][ni][4 * q4 + 3]);
            *(uint2*)(e.vT + (size_t)col * NTOK + row) = pk;
            if (row < NCTX) {
#pragma unroll
              for (int j = 0; j < 4; ++j) __builtin_nontemporal_store(acc[mi][ni][4 * q4 + j], &e.outv[(size_t)(row + j) * 512 + col]);
            }
          }
        }
    } else {
#pragma unroll
      for (int mi = 0; mi < 2; ++mi)
#pragma unroll
        for (int r = 0; r < 16; ++r) {
          const int row = m0 + wr * 64 + mi * 32 + (r & 3) + 8 * (r >> 2) + 4 * lh;
#pragma unroll
          for (int ni = 0; ni < 2; ++ni) {
            const int col = cb + ni * 32 + l31;
            const float v = acc[mi][ni][r];
            if (sec == 3) __builtin_nontemporal_store(v, &e.xb[(size_t)row * 512 + col]);
            else {
              const float t = tanhf(0.7978845608028654f * (v + 0.044715f * v * v * v));
              __builtin_nontemporal_store(f2bf(0.5f * v * (1.f + t)), &e.gg[(size_t)row * 512 + col]);
            }
          }
        }
    }
  } else if constexpr (EPI == EPI_DFTT) {
#pragma unroll
    for (int mi = 0; mi < 2; ++mi)
#pragma unroll
      for (int r = 0; r < 16; ++r) {
        const int m = m0 + wr * 64 + mi * 32 + (r & 3) + 8 * (r >> 2) + 4 * lh;
        const int cs = m >= e.T ? 1 : 0;
        const int kt = m - cs * e.T;
#pragma unroll
        for (int ni = 0; ni < 2; ++ni) {
          const int d = n0 + wc * 64 + ni * 32 + l31;
          __builtin_nontemporal_store(f2bf(acc[mi][ni][r]), &e.outb[(size_t)(e.tok0 + kt) * 2048 + (d >> 8) * 512 + cs * 256 + (d & 255)]);
        }
      }
  } else {
#pragma unroll
    for (int mi = 0; mi < MI; ++mi)
#pragma unroll
      for (int r = 0; r < 16; ++r) {
        const int row = m0 + wr * (MI * 32) + mi * 32 + (r & 3) + 8 * (r >> 2) + 4 * lh;
#pragma unroll
        for (int ni = 0; ni < NI; ++ni) {
          const int col = n0 + wc * (NI * 32) + ni * 32 + l31;
          e.outb[(size_t)row * e.ldc + col] = f2bf(acc[mi][ni][r]);
        }
      }
  }
}

__device__ __forceinline__ void tc_tile(const float* __restrict__ src, int lds_, u16* __restrict__ dst, int ldd,
                                        int k0, int n0, int mode, float* sT) {
  const int tid = TID();
  const int r = tid >> 4, c4 = (tid & 15) * 4;
#pragma unroll
  for (int p = 0; p < 4; ++p) {
    const float4 v = *(const float4*)(src + (size_t)(k0 + r + 16 * p) * lds_ + n0 + c4);
    float* d = sT + (r + 16 * p) * 65 + c4;
    d[0] = v.x; d[1] = v.y; d[2] = v.z; d[3] = v.w;
  }
  __syncthreads();
  const int n = tid >> 2, kq = (tid & 3) * 16;
  unsigned w[8];
#pragma unroll
  for (int j = 0; j < 8; ++j) w[j] = pack2(sT[(kq + 2 * j) * 65 + n], sT[(kq + 2 * j + 1) * 65 + n]);
  const int gn = n0 + n;
  const int drow = mode == 0 ? gn : ((gn >> 5) * 64 + (mode - 1) * 32 + (gn & 31));
  uint4* dp = (uint4*)(dst + (size_t)drow * ldd + k0 + kq);
  dp[0] = make_uint4(w[0], w[1], w[2], w[3]);
  dp[1] = make_uint4(w[4], w[5], w[6], w[7]);
  __syncthreads();
}

__device__ __forceinline__ void mod_item(int item, const Params& p, char* smem) {
  const int l = item / 144, cb = item % 144;
  const int tid = TID();
  float* sS = (float*)smem;
  float* sR = sS + 3072;
  {
    float cv[12];
#pragma unroll
    for (int q = 0; q < 12; ++q) {
      const int i = tid + 256 * q, ci = i >> 10, k = i & 1023;
      const float* src = ci == 0 ? p.in[7] : p.in[6] + (ci - 1) * 1024;
      cv[q] = src[k];
    }
    asm volatile("" ::: "memory"); __builtin_amdgcn_sched_barrier(0);
#pragma unroll
    for (int q = 0; q < 12; ++q) sS[tid + 256 * q] = cv[q] * sigmoidf_(cv[q]);
  }
  __syncthreads();
  const int c4 = (tid & 15) * 4, ks = tid >> 4;
  float acc[3][4];
#pragma unroll
  for (int a = 0; a < 3; ++a)
#pragma unroll
    for (int b = 0; b < 4; ++b) acc[a][b] = 0.f;
  const float* wp = p.in[8] + ((size_t)l * 1024 + ks * 64) * 9216 + cb * 64 + c4;
  typedef float v4f __attribute__((ext_vector_type(4)));
  for (int kk0 = 0; kk0 < 64; kk0 += 16) {
    v4f w[16];
#pragma unroll
    for (int i = 0; i < 16; ++i) w[i] = __builtin_nontemporal_load((const v4f*)(wp + (size_t)(kk0 + i) * 9216));
    asm volatile("" ::: "memory"); __builtin_amdgcn_sched_barrier(0);
#pragma unroll
    for (int i = 0; i < 16; ++i) {
      const int k = ks * 64 + kk0 + i;
#pragma unroll
      for (int ci = 0; ci < 3; ++ci) {
        const float s = sS[ci * 1024 + k];
        acc[ci][0] += s * w[i].x; acc[ci][1] += s * w[i].y; acc[ci][2] += s * w[i].z; acc[ci][3] += s * w[i].w;
      }
    }
  }
#pragma unroll
  for (int ci = 0; ci < 3; ++ci)
#pragma unroll
    for (int b = 0; b < 4; ++b) sR[(ks * 3 + ci) * 64 + c4 + b] = acc[ci][b];
  __syncthreads();
  if (tid < 192) {
    const int ci = tid >> 6, cc = tid & 63;
    float s = p.in[9][l * 9216 + cb * 64 + cc];
#pragma unroll
    for (int k2 = 0; k2 < 16; ++k2) s += sR[(k2 * 3 + ci) * 64 + cc];
    ((float*)(p.ws + WS_MOD))[(l * 3 + ci) * 9216 + cb * 64 + cc] = s;
  }
  __syncthreads();
}

struct TcJob { const float* src; u16* dst; int lds_, ldd, k0, n0, mode; };
__device__ __forceinline__ TcJob tc_decode(int t, const Params& p) {
  TcJob j;
  if (t < 2816) {
    const int m = t / 704, rem = t % 704, isup = rem / 352, tt = rem % 352;
    const int l = m >> 1, f = m & 1;
    j.src = p.in[f == 0 ? (isup ? 12 : 11) : (isup ? 15 : 14)] + (size_t)l * 1024 * DFF; j.lds_ = DFF;
    j.dst = (u16*)(p.ws + WS_WGU) + (size_t)m * 5632 * 1024; j.ldd = 1024;
    j.k0 = (tt / 22) * 64; j.n0 = (tt % 22) * 128; j.mode = 1 + isup;
    return j;
  }
  t -= 2816;
  if (t < 1408) {
    const int m = t / 352, tt = t % 352;
    const int l = m >> 1, f = m & 1;
    j.src = p.in[f == 0 ? 13 : 16] + (size_t)l * DFF * 1024; j.lds_ = 1024;
    j.dst = (u16*)(p.ws + WS_WD) + (size_t)m * 1024 * DFF; j.ldd = DFF;
    j.k0 = (tt / 8) * 64; j.n0 = (tt % 8) * 128; j.mode = 0;
    return j;
  }
  t -= 1408;
  if (t < 320) { j.src = p.in[17]; j.lds_ = 2560; j.dst = (u16*)(p.ws + WS_WIN); j.ldd = 1024; j.k0 = (t / 20) * 64; j.n0 = (t % 20) * 128; j.mode = 0; return j; }
  t -= 320;
  if (t < 128) { j.src = p.in[28]; j.lds_ = 1024; j.dst = (u16*)(p.ws + WS_WOAB); j.ldd = 1024; j.k0 = (t / 8) * 64; j.n0 = (t % 8) * 128; j.mode = 0; return j; }
  t -= 128;
  if (t < 128) { j.src = p.in[29]; j.lds_ = 1024; j.dst = (u16*)(p.ws + WS_WOC); j.ldd = 1024; j.k0 = (t / 8) * 64; j.n0 = (t % 8) * 128; j.mode = 0; return j; }
  t -= 128;
  {
    const int b = t / 16, r = t % 16;
    j.src = p.in[3] + (size_t)b * 256 * 512; j.lds_ = 512; j.dst = (u16*)(p.ws + WS_CVT) + (size_t)b * 512 * 256; j.ldd = 256;
    j.k0 = (r / 4) * 64; j.n0 = (r % 4) * 128; j.mode = 0;
    return j;
  }
}
constexpr int N_TC = 2816 + 1408 + 320 + 128 + 128 + 32;

struct TcPlan { int s[4]; int n[4]; };
__device__ __forceinline__ int tc_map(const TcPlan& pl, int v) {
#pragma unroll
  for (int i = 0; i < 4; ++i) { if (v < pl.n[i]) return pl.s[i] + v; v -= pl.n[i]; }
  return -1;
}
__device__ __forceinline__ void tc_run(const Params& p, char* smem, const TcPlan& pl, int rank, int nranks) {
  float* sT = (float*)smem;
  const int total = pl.n[0] + pl.n[1] + pl.n[2] + pl.n[3];
  const int tid = TID();
  const int lr = tid >> 5, lc4 = (tid & 31) * 4;
  typedef float v4f_nt __attribute__((ext_vector_type(4)));
  v4f_nt v[8];
  TcJob cur{}, nxt{};
  int t = rank;
  bool have = t < total;
  if (have) {
    cur = tc_decode(tc_map(pl, t), p);
#pragma unroll
    for (int q = 0; q < 8; ++q) v[q] = __builtin_nontemporal_load((const v4f_nt*)(cur.src + (size_t)(cur.k0 + lr + 8 * q) * cur.lds_ + cur.n0 + lc4));
  }
  while (have) {
#pragma unroll
    for (int q = 0; q < 8; ++q) {
      float* d = sT + (lr + 8 * q) * 129 + lc4;
      d[0] = v[q].x; d[1] = v[q].y; d[2] = v[q].z; d[3] = v[q].w;
    }
    __syncthreads();
    const int tn = t + nranks;
    const bool haven = tn < total;
    if (haven) {
      nxt = tc_decode(tc_map(pl, tn), p);
#pragma unroll
      for (int q = 0; q < 8; ++q) v[q] = __builtin_nontemporal_load((const v4f_nt*)(nxt.src + (size_t)(nxt.k0 + lr + 8 * q) * nxt.lds_ + nxt.n0 + lc4));
    }
    {
      const int n = tid & 127, kq = (tid >> 7) * 32;
      unsigned w[16];
#pragma unroll
      for (int j = 0; j < 16; ++j) w[j] = pack2(sT[(kq + 2 * j) * 129 + n], sT[(kq + 2 * j + 1) * 129 + n]);
      const int gn = cur.n0 + n;
      const int drow = cur.mode == 0 ? gn : ((gn >> 5) * 64 + (cur.mode - 1) * 32 + (gn & 31));
      uint4* dp = (uint4*)(cur.dst + (size_t)drow * cur.ldd + cur.k0 + kq);
      dp[0] = make_uint4(w[0], w[1], w[2], w[3]);
      dp[1] = make_uint4(w[4], w[5], w[6], w[7]);
      dp[2] = make_uint4(w[8], w[9], w[10], w[11]);
      dp[3] = make_uint4(w[12], w[13], w[14], w[15]);
    }
    __syncthreads();
    cur = nxt; t = tn; have = haven;
  }
}

__device__ void phase_prep(const Params& p, char* smem) {
  float* sT = (float*)smem;
  const int b = blockIdx.x, nb = gridDim.x;
  for (int t = b; t < 288; t += nb) mod_item(t, p, smem);
  for (int t = b; t < 32; t += nb) {
    const int dir = t / 16, blk = (t / 2) % 8, gate = t % 2;
    tc_tile(p.in[gate ? 25 : 23] + (size_t)(dir * 8 + blk) * 4096, 64,
            (u16*)(p.ws + WS_LRUW) + (size_t)((dir * 8 + blk) * 2 + gate) * 4096, 64, 0, 0, 0, sT);
  }
  {
    const TcPlan pl{{0, 4800, 0, 0}, {704, 32, 0, 0}};
    if (nb > 352) { if (b >= 288) tc_run(p, smem, pl, b - 288, nb - 288); }
    else tc_run(p, smem, pl, b, nb);
  }
  const int gt = blockIdx.x * 256 + TID(), gs = gridDim.x * 256;
  u16* ct256 = (u16*)(p.ws + WS_CT256);
  for (int i = gt; i < 512 * 256; i += gs) {
    const int m = i >> 8, t = i & 255, cs = m >> 8, kt = m & 255;
    const float ang = 2.f * (float)((kt * t) & 255) * (1.f / 256.f);
    ct256[i] = f2bf((cs ? sinpif(ang) : cospif(ang)) * 0.0625f);
  }
  u16* ct1024 = (u16*)(p.ws + WS_CT1024);
  for (int i = gt; i < 2048 * 1024; i += gs) {
    const int m = i >> 10, t = i & 1023, cs = m >> 10, kt = m & 1023;
    const float ang = 2.f * (float)((kt * t) & 1023) * (1.f / 1024.f);
    ct1024[i] = f2bf((cs ? sinpif(ang) : cospif(ang)) * 0.03125f);
  }
  u16* cs2 = (u16*)(p.ws + WS_CS2);
  for (int i = gt; i < 256 * 512; i += gs) {
    const int kc = i >> 9, r = i & 511, cs = r >> 8, c = r & 255;
    const float ang = 2.f * (float)((kc * c) & 255) * (1.f / 256.f);
    cs2[i] = f2bf((cs ? -sinpif(ang) : cospif(ang)) * 0.0625f);
  }
  u16* ckb = (u16*)(p.ws + WS_CKB);
  for (int i = gt; i < 2 * 256 * 512; i += gs) ckb[i] = f2bf(p.in[2][i]);
}

__device__ __forceinline__ const float* xrow(const float* x0, const float* x1, int row) {
  return (row < NCTX ? x0 : x1 - (size_t)NCTX * DM) + (size_t)row * DM;
}

__device__ void phase_norm(const Params& p, const float* x0, const float* x1, int l, int which) {
  const int lane = TID() & 63, wid = TID() >> 6;
  const float* g = p.in[10] + (l * 3 + which) * 1024;
  const float* mod = (const float*)(p.ws + WS_MOD) + (size_t)l * 3 * 9216 + which * 3 * 1024;
  u16* hn = (u16*)(p.ws + (((l * 3 + which) & 1) ? WS_HNB : WS_HN));
  const int nw = gridDim.x * 4;
  float4 gv[4];
#pragma unroll
  for (int j = 0; j < 4; ++j) gv[j] = *(const float4*)(g + j * 256 + lane * 4);
  for (int base = blockIdx.x * 4 + wid; base < NTOK; base += 3 * nw) {
    float4 v[3][4], sh[3][4], sc[3][4];
#pragma unroll
    for (int j3 = 0; j3 < 3; ++j3) {
      int row = base + j3 * nw; row = row < NTOK ? row : NTOK - 1;
      const float* xr = xrow(x0, x1, row);
      const float* mp = mod + cond_of(row) * 9216;
#pragma unroll
      for (int j = 0; j < 4; ++j) {
        v[j3][j] = *(const float4*)(xr + j * 256 + lane * 4);
        sh[j3][j] = *(const float4*)(mp + j * 256 + lane * 4);
        sc[j3][j] = *(const float4*)(mp + 1024 + j * 256 + lane * 4);
      }
    }
    asm volatile("" : "+v"(v[1][0].x), "+v"(v[1][1].x), "+v"(v[1][2].x), "+v"(v[1][3].x), "+v"(v[2][0].x), "+v"(v[2][1].x), "+v"(v[2][2].x), "+v"(v[2][3].x),
                      "+v"(sh[1][0].x), "+v"(sh[1][1].x), "+v"(sh[1][2].x), "+v"(sh[1][3].x), "+v"(sh[2][0].x), "+v"(sh[2][1].x), "+v"(sh[2][2].x), "+v"(sh[2][3].x),
                      "+v"(sc[1][0].x), "+v"(sc[1][1].x), "+v"(sc[1][2].x), "+v"(sc[1][3].x), "+v"(sc[2][0].x), "+v"(sc[2][1].x), "+v"(sc[2][2].x), "+v"(sc[2][3].x));
#pragma unroll
    for (int j3 = 0; j3 < 3; ++j3) {
      const int row = base + j3 * nw;
      float ss = 0.f;
#pragma unroll
      for (int j = 0; j < 4; ++j) ss += v[j3][j].x * v[j3][j].x + v[j3][j].y * v[j3][j].y + v[j3][j].z * v[j3][j].z + v[j3][j].w * v[j3][j].w;
#pragma unroll
      for (int o = 1; o < 64; o <<= 1) ss += __shfl_xor(ss, o);
      const float rs = rsqrtf(ss * (1.f / 1024.f) + 1e-6f);
      if (row < NTOK) {
#pragma unroll
        for (int j = 0; j < 4; ++j) {
          const int c = j * 256 + lane * 4;
          uint2 pk;
          pk.x = pack2(v[j3][j].x * rs * gv[j].x * (1.f + sc[j3][j].x) + sh[j3][j].x, v[j3][j].y * rs * gv[j].y * (1.f + sc[j3][j].y) + sh[j3][j].y);
          pk.y = pack2(v[j3][j].z * rs * gv[j].z * (1.f + sc[j3][j].z) + sh[j3][j].z, v[j3][j].w * rs * gv[j].w * (1.f + sc[j3][j].w) + sh[j3][j].w);
          st_wt((uint2*)(hn + (size_t)row * DM + c), pk);
        }
      }
    }
  }
}

__device__ void phase_normT(const Params& p, const float* x0, const float* x1, int l, int which, char* smem) {
  const int tid = TID(), lane = tid & 63, wid = tid >> 6;
  const float* g = p.in[10] + (l * 3 + which) * 1024;
  const float* mod = (const float*)(p.ws + WS_MOD) + (size_t)l * 3 * 9216 + which * 3 * 1024;
  u16* hnT = (u16*)(p.ws + (((l * 3 + which) & 1) ? WS_HNB : WS_HN));
  u16* sT = (u16*)smem;
  float4 gv[4];
#pragma unroll
  for (int j = 0; j < 4; ++j) gv[j] = *(const float4*)(g + j * 256 + lane * 4);
  for (int item = blockIdx.x; item < NTOK / 32; item += gridDim.x) {
    const int tokb = item * 32;
    for (int rr0 = wid; rr0 < 32; rr0 += 8) {
      float4 v[2][4], sh[2][4], sc[2][4];
#pragma unroll
      for (int q = 0; q < 2; ++q) {
        const int row = tokb + rr0 + 4 * q;
        const float* xr = xrow(x0, x1, row);
        const float* mp = mod + cond_of(row) * 9216;
#pragma unroll
        for (int j = 0; j < 4; ++j) {
          v[q][j] = *(const float4*)(xr + j * 256 + lane * 4);
          sh[q][j] = *(const float4*)(mp + j * 256 + lane * 4);
          sc[q][j] = *(const float4*)(mp + 1024 + j * 256 + lane * 4);
        }
      }
      asm volatile("" : "+v"(v[0][0].x), "+v"(v[0][1].x), "+v"(v[0][2].x), "+v"(v[0][3].x), "+v"(v[1][0].x), "+v"(v[1][1].x), "+v"(v[1][2].x), "+v"(v[1][3].x),
                        "+v"(sh[0][0].x), "+v"(sh[0][1].x), "+v"(sh[0][2].x), "+v"(sh[0][3].x), "+v"(sh[1][0].x), "+v"(sh[1][1].x), "+v"(sh[1][2].x), "+v"(sh[1][3].x),
                        "+v"(sc[0][0].x), "+v"(sc[0][1].x), "+v"(sc[0][2].x), "+v"(sc[0][3].x), "+v"(sc[1][0].x), "+v"(sc[1][1].x), "+v"(sc[1][2].x), "+v"(sc[1][3].x));
#pragma unroll
      for (int q = 0; q < 2; ++q) {
        const int rr = rr0 + 4 * q;
        float ss = 0.f;
#pragma unroll
        for (int j = 0; j < 4; ++j) ss += v[q][j].x * v[q][j].x + v[q][j].y * v[q][j].y + v[q][j].z * v[q][j].z + v[q][j].w * v[q][j].w;
#pragma unroll
        for (int o = 1; o < 64; o <<= 1) ss += __shfl_xor(ss, o);
        const float rs = rsqrtf(ss * (1.f / 1024.f) + 1e-6f);
#pragma unroll
        for (int j = 0; j < 4; ++j) {
          const int c = j * 256 + lane * 4;
          u16* d = sT + rr * 1026 + c;
          d[0] = f2bf(v[q][j].x * rs * gv[j].x * (1.f + sc[q][j].x) + sh[q][j].x);
          d[1] = f2bf(v[q][j].y * rs * gv[j].y * (1.f + sc[q][j].y) + sh[q][j].y);
          d[2] = f2bf(v[q][j].z * rs * gv[j].z * (1.f + sc[q][j].z) + sh[q][j].z);
          d[3] = f2bf(v[q][j].w * rs * gv[j].w * (1.f + sc[q][j].w) + sh[q][j].w);
        }
      }
    }
    __syncthreads();
    int base, T, t0;
    if (tokb < NCTX) { base = (tokb >> 8) << 8; T = 256; t0 = tokb & 255; }
    else { base = NCTX + (((tokb - NCTX) >> 10) << 10); T = 1024; t0 = (tokb - NCTX) & 1023; }
#pragma unroll 4
    for (int it = 0; it < 16; ++it) {
      const int u = tid + 256 * it;
      const int d = u & 1023, tq = u >> 10;
      unsigned w[4];
#pragma unroll
      for (int j = 0; j < 4; ++j)
        w[j] = (unsigned)sT[(tq * 8 + 2 * j) * 1026 + d] | ((unsigned)sT[(tq * 8 + 2 * j + 1) * 1026 + d] << 16);
      *(uint4*)(hnT + (size_t)base * 1024 + (size_t)d * T + t0 + tq * 8) = make_uint4(w[0], w[1], w[2], w[3]);
    }
    __syncthreads();
  }
}

__device__ __forceinline__ void attn_item(int item, const Params& p, char* smem) {
  const int tid = TID(), lane = tid & 63, w = tid >> 6, l15 = lane & 15, g = lane >> 4;
  u16* sQ = (u16*)smem;
  u16* sK = sQ + 64 * 72;
  u16* sV = sK + 64 * 72;
  float* sRpb = (float*)(sQ + 5 * 64 * 72);
  const u16* QB = (const u16*)(p.ws + WS_Q);
  const u16* KB = (const u16*)(p.ws + WS_K);
  const u16* VT = (const u16*)(p.ws + WS_VT);
  const u16* CKB = (const u16*)(p.ws + WS_CKB);
  const u16* CVT = (const u16*)(p.ws + WS_CVT);
  u16* MIX = (u16*)(p.ws + WS_MIX);
  bool sample; int b, h, r = 0, rs = 0, tokq0, tok0, ntiles;
  if (item < 256) { sample = true; b = item >> 7; h = (item >> 4) & 7; r = item & 15; tok0 = NCTX + b * 1024; tokq0 = tok0 + r * 64; ntiles = 12;
    rs = r - 4; rs = rs < 0 ? 0 : (rs > 8 ? 8 : rs); }
  else { const int it = item - 256; sample = false; b = it >> 5; h = (it >> 2) & 7; tok0 = b * 256; tokq0 = tok0 + (it & 3) * 64; ntiles = 4; }
  const int lrow = tid >> 3, lseg = tid & 7;
#pragma unroll
  for (int i = 0; i < 2; ++i)
    *(uint4*)(sQ + (lrow + 32 * i) * 72 + lseg * 8) = *(const uint4*)(QB + (size_t)(tokq0 + lrow + 32 * i) * 512 + h * 64 + lseg * 8);
  if (sample) for (int i = tid; i < 465; i += 256) sRpb[i] = p.in[20][h * 465 + i];
  const int qc = 16 * w + l15;
  int cs = qc - 8; cs = cs < 0 ? 0 : (cs > 48 ? 48 : cs);
  float m_run = -1e30f, l_run = 0.f;
  f32x4 o[4];
#pragma unroll
  for (int mt = 0; mt < 4; ++mt) o[mt] = f32x4{0.f, 0.f, 0.f, 0.f};
  typedef unsigned v4u __attribute__((ext_vector_type(4)));
#define ATT_PTRS(TILE, KP, VP, VS) { \
    if (sample && (TILE) < 4) { KP = CKB + (size_t)(b * 256 + 64 * (TILE)) * 512 + h * 64; VP = CVT + (size_t)(b * 512 + h * 64) * 256 + 64 * (TILE); VS = 256; } \
    else if (sample) { const int kr_ = rs + (TILE) - 4; KP = KB + (size_t)(tok0 + kr_ * 64) * 512 + h * 64; VP = VT + (size_t)(h * 64) * NTOK + tok0 + kr_ * 64; VS = NTOK; } \
    else { KP = KB + (size_t)(tok0 + 64 * (TILE)) * 512 + h * 64; VP = VT + (size_t)(h * 64) * NTOK + tok0 + 64 * (TILE); VS = NTOK; } }
  v4u rk0, rk1, rv0, rv1;
  {
    const u16 *kptr, *vptr; int vstride;
    ATT_PTRS(0, kptr, vptr, vstride)
    rk0 = *(const v4u*)(kptr + (size_t)lrow * 512 + lseg * 8);
    rk1 = *(const v4u*)(kptr + (size_t)(lrow + 32) * 512 + lseg * 8);
    rv0 = *(const v4u*)(vptr + (size_t)lrow * vstride + lseg * 8);
    rv1 = *(const v4u*)(vptr + (size_t)(lrow + 32) * vstride + lseg * 8);
  }
  *(v4u*)(sK + lrow * 72 + lseg * 8) = rk0; *(v4u*)(sK + (lrow + 32) * 72 + lseg * 8) = rk1;
  *(v4u*)(sV + lrow * 72 + lseg * 8) = rv0; *(v4u*)(sV + (lrow + 32) * 72 + lseg * 8) = rv1;
  __syncthreads();
  bf16x8 bq[2];
#pragma unroll
  for (int ks = 0; ks < 2; ++ks) bq[ks] = *(const bf16x8*)(sQ + (16 * w + l15) * 72 + 32 * ks + 8 * g);
  for (int tile = 0; tile < ntiles; ++tile) {
    const int cur = tile & 1;
    const u16* cK = sK + cur * (2 * 64 * 72);
    const u16* cV = sV + cur * (2 * 64 * 72);
    const bool local = sample && tile >= 4;
    const int dr = local ? (rs + tile - 4) - r + 7 : 0;
    {
      const int tn = tile + 1 < ntiles ? tile + 1 : tile;
      const u16 *kptr, *vptr; int vstride;
      ATT_PTRS(tn, kptr, vptr, vstride)
      rk0 = *(const v4u*)(kptr + (size_t)lrow * 512 + lseg * 8);
      rk1 = *(const v4u*)(kptr + (size_t)(lrow + 32) * 512 + lseg * 8);
      rv0 = *(const v4u*)(vptr + (size_t)lrow * vstride + lseg * 8);
      rv1 = *(const v4u*)(vptr + (size_t)(lrow + 32) * vstride + lseg * 8);
    }
    f32x4 s[4];
#pragma unroll
    for (int nt = 0; nt < 4; ++nt) {
      s[nt] = f32x4{0.f, 0.f, 0.f, 0.f};
#pragma unroll
      for (int ks = 0; ks < 2; ++ks) {
        const bf16x8 a = *(const bf16x8*)(cK + (16 * nt + l15) * 72 + 32 * ks + 8 * g);
        s[nt] = __builtin_amdgcn_mfma_f32_16x16x32_bf16(a, bq[ks], s[nt], 0, 0, 0);
      }
    }
    if (local) {
#pragma unroll
      for (int nt = 0; nt < 4; ++nt)
#pragma unroll
        for (int i = 0; i < 4; ++i) {
          const int kc = 16 * nt + 4 * g + i;
          const bool valid = kc >= cs && kc < cs + 16;
          int bi = kc - qc + 15; bi = bi < 0 ? 0 : (bi > 30 ? 30 : bi);
          s[nt][i] = valid ? s[nt][i] + sRpb[dr * 31 + bi] : -1e30f;
        }
    }
    float tmax = -1e30f;
#pragma unroll
    for (int nt = 0; nt < 4; ++nt)
#pragma unroll
      for (int i = 0; i < 4; ++i) tmax = fmaxf(tmax, s[nt][i]);
    tmax = fmaxf(tmax, __shfl_xor(tmax, 16));
    tmax = fmaxf(tmax, __shfl_xor(tmax, 32));
    const float m_new = fmaxf(m_run, tmax);
    const float alpha = __expf(m_run - m_new);
    m_run = m_new;
    float ps = 0.f;
#pragma unroll
    for (int nt = 0; nt < 4; ++nt)
#pragma unroll
      for (int i = 0; i < 4; ++i) { s[nt][i] = __expf(s[nt][i] - m_new); ps += s[nt][i]; }
    l_run = l_run * alpha + ps;
#pragma unroll
    for (int mt = 0; mt < 4; ++mt)
#pragma unroll
      for (int i = 0; i < 4; ++i) o[mt][i] *= alpha;
#pragma unroll
    for (int s2 = 0; s2 < 2; ++s2) {
      union { bf16x8 v; unsigned u[4]; } bp;
      bp.u[0] = pack2(s[2 * s2][0], s[2 * s2][1]);
      bp.u[1] = pack2(s[2 * s2][2], s[2 * s2][3]);
      bp.u[2] = pack2(s[2 * s2 + 1][0], s[2 * s2 + 1][1]);
      bp.u[3] = pack2(s[2 * s2 + 1][2], s[2 * s2 + 1][3]);
#pragma unroll
      for (int mt = 0; mt < 4; ++mt) {
        union { bf16x8 v; uint2 u[2]; } av;
        av.u[0] = *(const uint2*)(cV + (16 * mt + l15) * 72 + 32 * s2 + 4 * g);
        av.u[1] = *(const uint2*)(cV + (16 * mt + l15) * 72 + 32 * s2 + 16 + 4 * g);
        o[mt] = __builtin_amdgcn_mfma_f32_16x16x32_bf16(av.v, bp.v, o[mt], 0, 0, 0);
      }
    }
    {
      u16* nK = sK + (cur ^ 1) * (2 * 64 * 72);
      u16* nV = sV + (cur ^ 1) * (2 * 64 * 72);
      *(v4u*)(nK + lrow * 72 + lseg * 8) = rk0; *(v4u*)(nK + (lrow + 32) * 72 + lseg * 8) = rk1;
      *(v4u*)(nV + lrow * 72 + lseg * 8) = rv0; *(v4u*)(nV + (lrow + 32) * 72 + lseg * 8) = rv1;
    }
    __syncthreads();
  }
#undef ATT_PTRS
  l_run += __shfl_xor(l_run, 16);
  l_run += __shfl_xor(l_run, 32);
  const float inv = 1.f / l_run;
#pragma unroll
  for (int mt = 0; mt < 4; ++mt) {
    uint2 pk;
    pk.x = pack2(o[mt][0] * inv, o[mt][1] * inv);
    pk.y = pack2(o[mt][2] * inv, o[mt][3] * inv);
    *(uint2*)(MIX + (size_t)(tokq0 + qc) * DM + h * 64 + 16 * mt + 4 * g) = pk;
  }
}

__device__ __forceinline__ void lru1_item(int item, const Params& p, char* smem) {
  const int tid = TID(), lane = tid & 63, wid = tid >> 6;
  const int ch = item >> 3, blk = item & 7;
  u16* sXc = (u16*)smem;
  float* sXf = (float*)(smem + 9216);
  u16* sW = (u16*)(smem + 9216 + 16384);
  float* sA = (float*)(smem + 9216 + 16384 + 18432);
  float* sU = sA + 4096;
  float* sSegA = sU + 4096;
  float* sSegH = sSegA + 256;
  const float* XB = (const float*)(p.ws + WS_XB);
  float* HL = (float*)(p.ws + WS_HL);
  float* AC = (float*)(p.ws + WS_Z);
  float* AGA = (float*)(p.ws + WS_AGGA);
  float* AGH = (float*)(p.ws + WS_AGGH);
  const int tokc = ch * 64;
  int T, t0;
  if (ch < 64) { T = 256; t0 = (ch & 3) * 64; } else { T = 1024; t0 = ((ch - 64) & 15) * 64; }
  const int seq0 = tokc - t0;
  {
    const int c = tid & 63, tq = tid >> 6, cg_ = blk * 64 + c;
    float xv[19];
#pragma unroll
    for (int i = 0; i < 19; ++i) {
      const int t = t0 + tq * 16 + i - 1;
      xv[i] = (t >= 0 && t < T) ? __builtin_nontemporal_load(&XB[(size_t)(seq0 + t) * 512 + cg_]) : 0.f;
    }
    const float w0 = p.in[21][cg_], w1 = p.in[21][512 + cg_], w2 = p.in[21][1024 + cg_], w3 = p.in[21][1536 + cg_];
    const float cb = p.in[22][cg_];
#pragma unroll
    for (int i = 0; i < 16; ++i) {
      const float xc = cb + w0 * xv[i] + w1 * xv[i + 1] + w2 * xv[i + 2] + w3 * xv[i + 3];
      sXf[(tq * 16 + i) * 64 + c] = xc;
      sXc[(tq * 16 + i) * 72 + c] = f2bf(xc);
    }
  }
  const int wr = wid >> 1, wc = wid & 1, l31 = lane & 31, lh = lane >> 5;
  typedef unsigned v4u_t __attribute__((ext_vector_type(4)));
  v4u_t wreg[2][4];
#pragma unroll
  for (int d = 0; d < 2; ++d) {
    const u16* wsrc = (const u16*)(p.ws + WS_LRUW) + (size_t)((d * 8 + blk) * 2) * 4096;
#pragma unroll
    for (int i = 0; i < 4; ++i) {
      const int idx = tid + 256 * i;
      wreg[d][i] = *(const v4u_t*)(wsrc + (idx >> 3) * 64 + (idx & 7) * 8);
    }
  }
  float pbr[2], pbi[2], plam[2];
  {
    const int cg2 = blk * 64 + 32 * wc + l31;
#pragma unroll
    for (int d = 0; d < 2; ++d) { pbr[d] = p.in[24][d * 512 + cg2]; pbi[d] = p.in[26][d * 512 + cg2]; plam[d] = p.in[27][d * 512 + cg2]; }
  }
#pragma unroll
  for (int dir = 0; dir < 2; ++dir) {
    {
#pragma unroll
      for (int i = 0; i < 4; ++i) {
        const int idx = tid + 256 * i;
        const int row = idx >> 3, seg = idx & 7;
        *(v4u_t*)(sW + row * 72 + seg * 8) = wreg[dir][i];
      }
    }
    __syncthreads();
    f32x16 aR, aI;
#pragma unroll
    for (int r = 0; r < 16; ++r) { aR[r] = 0.f; aI[r] = 0.f; }
#pragma unroll
    for (int ks = 0; ks < 4; ++ks) {
      const bf16x8 a = *(const bf16x8*)(sXc + (32 * wr + l31) * 72 + 16 * ks + 8 * lh);
      const bf16x8 br = *(const bf16x8*)(sW + (32 * wc + l31) * 72 + 16 * ks + 8 * lh);
      const bf16x8 bi = *(const bf16x8*)(sW + (64 + 32 * wc + l31) * 72 + 16 * ks + 8 * lh);
      aR = __builtin_amdgcn_mfma_f32_32x32x16_bf16(a, br, aR, 0, 0, 0);
      aI = __builtin_amdgcn_mfma_f32_32x32x16_bf16(a, bi, aI, 0, 0, 0);
    }
    {
      const int c = 32 * wc + l31, cg_ = blk * 64 + c;
      const float br_ = pbr[dir], bi_ = pbi[dir];
      const float lam = plam[dir];
      const float ls = -log1pf(expf(-lam));
#pragma unroll
      for (int r = 0; r < 16; ++r) {
        const int t = 32 * wr + (r & 3) + 8 * (r >> 2) + 4 * lh;
        const float rg = 1.f / (1.f + __expf(-(aR[r] + br_)));
        const float ig = 1.f / (1.f + __expf(-(aI[r] + bi_)));
        const float la = 8.f * rg * ls;
        float em = la * (1.f + la * (0.5f + la * (0.16666667f + la * (0.041666668f + la * (0.0083333338f + la * 0.0013888889f)))));
        if (la < -0.3f) em = expm1f(la);
        const float a = 1.f + em;
        const float u = sqrtf(-em * (2.f + em)) * (ig * sXf[t * 64 + c]);
        sA[t * 64 + c] = a;
        sU[t * 64 + c] = u;
      }
    }
    __syncthreads();
    {
      const int c = tid & 63, seg = tid >> 6, cg_ = blk * 64 + c;
      float hh = 0.f, AA = 1.f;
#pragma unroll
      for (int i = 0; i < 16; ++i) {
        const int n = seg * 16 + i;
        const int t = dir ? 63 - n : n;
        const float a = sA[t * 64 + c], u = sU[t * 64 + c];
        hh = a * hh + u; AA *= a;
        sU[t * 64 + c] = hh; sA[t * 64 + c] = AA;
      }
      sSegA[seg * 64 + c] = AA; sSegH[seg * 64 + c] = hh;
      __syncthreads();
      float cin = 0.f, P = 1.f;
#pragma unroll
      for (int s2 = 0; s2 < 3; ++s2) {
        if (s2 < seg) { const float a = sSegA[s2 * 64 + c]; cin = a * cin + sSegH[s2 * 64 + c]; P *= a; }
      }
      float hl_last = 0.f;
#pragma unroll
      for (int i = 0; i < 16; ++i) {
        const int n = seg * 16 + i;
        const int t = dir ? 63 - n : n;
        const float acs = sA[t * 64 + c];
        const float hl = sU[t * 64 + c] + acs * cin;
        const size_t gi = ((size_t)dir * NTOK + tokc + t) * 512 + cg_;
        __builtin_nontemporal_store(hl, &HL[gi]); __builtin_nontemporal_store(acs * P, &AC[gi]);
        hl_last = hl;
      }
      if (seg == 3) {
        AGA[(dir * 96 + ch) * 512 + cg_] = sSegA[3 * 64 + c] * P;
        AGH[(dir * 96 + ch) * 512 + cg_] = hl_last;
      }
    }
    __syncthreads();
  }
}

__device__ __forceinline__ void lru2_item(int item, const Params& p) {
  const int tid = TID();
  const int ch = item >> 4, qd = (item >> 2) & 3, tq = item & 3;
  const int c = qd * 128 + (tid & 127), th = tid >> 7;
  const float* HL = (const float*)(p.ws + WS_HL);
  const float* AC = (const float*)(p.ws + WS_Z);
  const float* AGA = (const float*)(p.ws + WS_AGGA);
  const float* AGH = (const float*)(p.ws + WS_AGGH);
  const u16* GG = (const u16*)(p.ws + WS_GG);
  u16* MIX = (u16*)(p.ws + WS_MIX);
  int first, nch; float cf, cb;
  if (ch < 64) { first = ch & ~3; nch = 4; cf = 0.f; cb = 0.f; }
  else { const int b = (ch - 64) >> 4; first = 64 + b * 16; nch = 16; cf = p.in[4][b * 512 + c]; cb = p.in[5][b * 512 + c]; }
  const int last = first + nch - 1;
  const int tokc = ch * 64, tb = tq * 16 + th * 8;
  float hl0[8], ac0[8], hl1[8], ac1[8], gg[8];
#pragma unroll
  for (int i = 0; i < 8; ++i) {
    const size_t g0 = ((size_t)tokc + tb + i) * 512 + c;
    const size_t g1 = g0 + (size_t)NTOK * 512;
    hl0[i] = __builtin_nontemporal_load(&HL[g0]); ac0[i] = __builtin_nontemporal_load(&AC[g0]);
    hl1[i] = __builtin_nontemporal_load(&HL[g1]); ac1[i] = __builtin_nontemporal_load(&AC[g1]); gg[i] = bf2f(__builtin_nontemporal_load(&GG[g0]));
  }
#pragma unroll
  for (int j = 0; j < 16; ++j) {
    int idx = first + j; const bool valid = idx < ch; idx = valid ? idx : first;
    const float a = AGA[(0 * 96 + idx) * 512 + c], hh = AGH[(0 * 96 + idx) * 512 + c];
    cf = valid ? a * cf + hh : cf;
  }
#pragma unroll
  for (int j = 0; j < 16; ++j) {
    int idx = last - j; const bool valid = idx > ch; idx = valid ? idx : last;
    const float a = AGA[(1 * 96 + idx) * 512 + c], hh = AGH[(1 * 96 + idx) * 512 + c];
    cb = valid ? a * cb + hh : cb;
  }
#pragma unroll
  for (int i = 0; i < 8; ++i) {
    const int t = tb + i;
    const float hf = hl0[i] + ac0[i] * cf;
    const float hb = hl1[i] + ac1[i] * cb;
    MIX[((size_t)tokc + t) * DM + 512 + c] = f2bf((hf + hb) * gg[i]);
    if (ch < 64) {
      if (t == 63 && (ch & 3) == 3) p.out[10485760 + (ch >> 2) * 512 + c] = hf;
      if (t == 0 && (ch & 3) == 0) p.out[10493952 + (ch >> 2) * 512 + c] = hb;
    }
  }
}

#define XB_TMO      128
#define XB_XCNT(j)  (256  + 64 * (j))
#define XB_XSUB(j)  (1280 + 64 * (j))
#define XB_XGEN(j)  (2304 + 64 * (j))
#define XB_TOP      3328
#define XB_TOPGEN   3392
#define XCD_BAR_WORDS 3456
#define XB_SPIN_CAP (1u << 18)
#define LAS __attribute__((address_space(3)))
__device__ __forceinline__ unsigned xb_ld(unsigned* p) { return __hip_atomic_load(p, __ATOMIC_RELAXED, __HIP_MEMORY_SCOPE_AGENT); }
__device__ __forceinline__ unsigned xb_add(unsigned* p, unsigned v) { return __hip_atomic_fetch_add(p, v, __ATOMIC_RELAXED, __HIP_MEMORY_SCOPE_AGENT); }
__device__ __forceinline__ unsigned xb_xcc_id() { return (unsigned)__builtin_amdgcn_s_getreg((3 << 11) | 20) & 0xFu; }
#define XB_SPIN(cond, bar) do { unsigned _sp = 0; while (cond) { __builtin_amdgcn_s_sleep(1); \
    if ((++_sp & 255u) == 0u) { if (xb_ld(&(bar)[XB_TMO])) break; if (_sp > XB_SPIN_CAP) { atomicAdd(&(bar)[XB_TMO], 1u); break; } } } } while (0)
struct XcdBarrier { unsigned* bar; unsigned x; volatile LAS unsigned* st; unsigned nloc, nx; };
__device__ __forceinline__ XcdBarrier xcd_barrier_post(unsigned* bar, volatile LAS unsigned* st) {
  XcdBarrier b; b.bar = bar; b.x = xb_xcc_id(); b.st = st; b.nloc = 0u; b.nx = 0u;
  if (threadIdx.x == 0) (void)xb_add(&bar[XB_XCNT(b.x)], 1u);
  return b;
}
__device__ __forceinline__ void xcd_barrier_complete(unsigned* bar, unsigned x, unsigned& nloc, unsigned& nx) {
  const unsigned G = gridDim.x * gridDim.y * gridDim.z;
  unsigned sum, cnt, mine, sp = 0u;
  for (;;) {
    sum = 0u; cnt = 0u; mine = 0u;
    unsigned cv[16];
#pragma unroll
    for (unsigned j = 0; j < 16; ++j) cv[j] = xb_ld(&bar[XB_XCNT(j)]);
    asm volatile("" ::: "memory"); __builtin_amdgcn_sched_barrier(0);
#pragma unroll
    for (unsigned j = 0; j < 16; ++j) { const unsigned c = cv[j]; sum += c; cnt += (c > 0u) ? 1u : 0u; mine = (j == x) ? c : mine; }
    if (sum == G) break;
    __builtin_amdgcn_s_sleep(1);
    if ((++sp & 255u) == 0u) { if (xb_ld(&bar[XB_TMO])) break; if (sp > XB_SPIN_CAP) { atomicAdd(&bar[XB_TMO], 1u); break; } }
  }
  nloc = mine > 0u ? mine : 1u; nx = cnt > 0u ? cnt : 1u;
}
__device__ __forceinline__ void xcd_barrier(XcdBarrier& b, bool acquire) {
  asm volatile("s_waitcnt vmcnt(0)" ::: "memory");
  __syncthreads();
  if (threadIdx.x == 0) {
    unsigned* bar = b.bar;
    __builtin_amdgcn_s_waitcnt(0);
    unsigned nloc = b.nloc, nx = b.nx;
    if (nloc == 0u) { xcd_barrier_complete(bar, b.x, nloc, nx); b.st[0] = nloc; b.st[1] = nx; }
    const unsigned old = xb_add(&bar[XB_XSUB(b.x)], 1u);
    const unsigned gen = old / nloc;
    if (old + 1u == (gen + 1u) * nloc) {
      __builtin_amdgcn_fence(__ATOMIC_RELEASE, "agent");
      asm volatile("s_waitcnt vmcnt(0)" ::: "memory");
      const unsigned og = xb_add(&bar[XB_TOP], 1u);
      const unsigned tg = og / nx;
      if (og + 1u == (tg + 1u) * nx) xb_add(&bar[XB_TOPGEN], 1u);
      else XB_SPIN(xb_ld(&bar[XB_TOPGEN]) == tg, bar);
      if (acquire) __builtin_amdgcn_fence(__ATOMIC_ACQUIRE, "agent");
      xb_add(&bar[XB_XGEN(b.x)], 1u);
      asm volatile("s_waitcnt vmcnt(0)" ::: "memory");
    } else {
      XB_SPIN(xb_ld(&bar[XB_XGEN(b.x)]) == gen, bar);
      if (acquire) __builtin_amdgcn_fence(__ATOMIC_ACQUIRE, "agent");
      asm volatile("s_waitcnt vmcnt(0)" ::: "memory");
    }
  }
  __syncthreads();
  if (b.nloc == 0u) { b.nloc = b.st[0]; b.nx = b.st[1]; }
}

enum { K_PREP, K_NORM0, K_GU1, K_DOWN1, K_NORM1, K_INPROJ, K_ATTLRU, K_LRU2, K_OUTAB, K_NORM2, K_GU2, K_DOWN2, K_NORMT, K_DFTT, K_DFTC, K_OUTC };
#define PHASE_FN __device__ __forceinline__

PHASE_FN void ph_prep(const Params& p, char* smem) { phase_prep(p, smem); }

PHASE_FN void ph_norm(const Params& p, int l, int kind, char* smem) {
  float* X = (float*)(p.ws + WS_X);
  const bool first = (l == 0 && kind == K_NORM0);
  const float* x0 = first ? p.in[0] : X;
  const float* x1 = first ? p.in[1] : X + (size_t)NCTX * DM;
  if (kind == K_NORMT) phase_normT(p, x0, x1, l, 1, smem);
  else phase_norm(p, x0, x1, l, kind == K_NORM0 ? 0 : kind == K_NORM1 ? 1 : 2);
}

PHASE_FN void ph_gu(const Params& p, int l, int f, char* smem) {
  EpiP e{}; e.outb = (u16*)(p.ws + (f ? WS_HL : WS_H));
  const u16* A = (const u16*)(p.ws + (((l * 3 + (f ? 2 : 0)) & 1) ? WS_HNB : WS_HN));
  const u16* Bt = (const u16*)(p.ws + WS_WGU) + (size_t)(l * 2 + f) * 5632 * 1024;
  for (int t = blockIdx.x; t < 32 * 44; t += gridDim.x)
    gemm_tile<EPI_SWIGLU, 2, 2, 3, 2>(A, 1024, Bt, 1024, 1024, (t % 32) * 192, (t / 32) * 128, e, smem);
  {
    const int nb = gridDim.x, extra = (32 * 44) % nb, b = blockIdx.x;
    TcPlan pl{{0, 0, 0, 0}, {0, 0, 0, 0}};
    if (l == 0 && f == 0) pl = TcPlan{{2816, 4224, 1088, 0}, {352, 320, 320, 0}};
    else if (l == 0 && f == 1) pl = TcPlan{{3168, 1408, 0, 0}, {352, 704, 0, 0}};
    else if (l == 1 && f == 0) pl = TcPlan{{3520, 4672, 2112, 0}, {352, 128, 704, 0}};
    else pl = TcPlan{{3872, 0, 0, 0}, {352, 0, 0, 0}};
    if (b >= extra) tc_run(p, smem, pl, b - extra, nb - extra);
  }
}

PHASE_FN void ph_resid(const Params& p, int l, int kind, int rep, char* smem) {
  float* X = (float*)(p.ws + WS_X);
  const bool first = (l == 0 && kind == K_DOWN1);
  const float* MOD = (const float*)(p.ws + WS_MOD) + (size_t)l * 3 * 9216;
  EpiP e{};
  const u16 *A, *Bt; int K, gi;
  if (kind == K_DOWN1 || kind == K_DOWN2) {
    const int f = kind == K_DOWN1 ? 0 : 1;
    A = (const u16*)(p.ws + (f ? WS_HL : WS_H)); K = DFF; Bt = (const u16*)(p.ws + WS_WD) + (size_t)(l * 2 + f) * 1024 * DFF;
    gi = f == 0 ? 2 : 8; e.gscale = 0.5f;
  } else if (kind == K_OUTAB) {
    A = (const u16*)(p.ws + WS_MIX); K = 1024; Bt = (const u16*)(p.ws + WS_WOAB); gi = 5; e.gscale = 1.f;
  } else {
    A = (const u16*)(p.ws + WS_F); K = 1024; Bt = (const u16*)(p.ws + WS_WOC); gi = 5; e.gscale = 1.f;
  }
  e.gate = MOD + gi * 1024;
  e.res0 = first ? p.in[0] : X;
  e.res1 = first ? p.in[1] : X + (size_t)NCTX * DM;
  e.outf = (l == 1 && kind == K_DOWN2) ? p.out : X;
  if (rep > 0) e.outf = (float*)(p.ws + WS_Z);
  for (int t = blockIdx.x; t < 64 * 8; t += gridDim.x)
    gemm_tile<EPI_RESID, 1, 4, 3, 1>(A, K, Bt, K, K, (t % 64) * 96, (t / 64) * 128, e, smem);
}

PHASE_FN void ph_inproj(const Params& p, char* smem) {
  EpiP e{};
  e.q = (u16*)(p.ws + WS_Q); e.k = (u16*)(p.ws + WS_K); e.vT = (u16*)(p.ws + WS_VT); e.gg = (u16*)(p.ws + WS_GG);
  e.xb = (float*)(p.ws + WS_XB); e.qg = p.in[18]; e.kg = p.in[19];
  e.outk = p.out + 6291456; e.outv = p.out + 8388608;
  const u16* A = (const u16*)(p.ws + WS_HNB);
  const u16* Bt = (const u16*)(p.ws + WS_WIN);
  for (int t = blockIdx.x; t < 48 * 20; t += gridDim.x)
    gemm_tile<EPI_INPROJ>(A, 1024, Bt, 1024, 1024, (t % 48) * 128, (t / 48) * 128, e, smem);
  {
    const int nb = gridDim.x, extra = (48 * 20) % nb, b = blockIdx.x;
    const TcPlan pl{{4544, 704, 0, 0}, {128, 384, 0, 0}};
    if (b >= extra) tc_run(p, smem, pl, b - extra, nb - extra);
  }
}

PHASE_FN void ph_attn(const Params& p, char* smem) {
  for (int t = blockIdx.x; t < 768; t += gridDim.x) { attn_item(t, p, smem); __syncthreads(); }
}
PHASE_FN void ph_lru1(const Params& p, char* smem) {
  const int nb = gridDim.x;
  for (int t = nb - 1 - (int)blockIdx.x; t < 768; t += nb) { lru1_item(t, p, smem); __syncthreads(); }
}
PHASE_FN void ph_lru2(const Params& p) {
  for (int t = blockIdx.x; t < 1536; t += gridDim.x) lru2_item(t, p);
}

PHASE_FN void ph_dftt(const Params& p, char* smem) {
  const u16* HNT = (const u16*)(p.ws + WS_HN);
  EpiP e{}; e.outb = (u16*)(p.ws + WS_Z2);
  const int nb = gridDim.x, b = blockIdx.x;
  for (int i = 0;; ++i) {
    int t;
    if (nb == 512) { if (b < 256) { if (i > 0) break; t = b; } else { if (i > 1) break; t = 256 + (b - 256) * 2 + i; } }
    else { t = b + i * nb; if (t >= 768) break; }
    const u16* A; int T, m0, n0;
    if (t < 256) { const int bb = t >> 7, r = t & 127; e.tok0 = NCTX + bb * 1024; T = 1024; A = (const u16*)(p.ws + WS_CT1024); m0 = (r & 15) * 128; n0 = (r >> 4) * 128; }
    else { const int t2 = t - 256, bb = t2 >> 5, r = t2 & 31; e.tok0 = bb * 256; T = 256; A = (const u16*)(p.ws + WS_CT256); m0 = (r & 3) * 128; n0 = (r >> 2) * 128; }
    e.T = T;
    gemm_tile<EPI_DFTT>(A, T, HNT + (size_t)e.tok0 * 1024, T, T, m0, n0, e, smem);
  }
}

PHASE_FN void ph_dftc(const Params& p, char* smem) {
  EpiP e{}; e.outb = (u16*)(p.ws + WS_F); e.ldc = 256;
  for (int t = blockIdx.x; t < 256 * 2; t += gridDim.x)
    gemm_tile<EPI_BF16, 1, 4, 3, 1>((const u16*)(p.ws + WS_Z2), 512, (const u16*)(p.ws + WS_CS2), 512, 512, (t >> 1) * 96, (t & 1) * 128, e, smem);
}

#ifndef REPMASK
#define REPMASK 0u
#define REPN 0
#endif
__device__ __forceinline__ int kind_of(int ph) {
  if (ph == 0) return K_PREP;
  if (ph <= 11) return ph;
  const int i = ph - 12;
  return i == 0 ? K_NORM0 : i == 1 ? K_GU1 : i == 2 ? K_DOWN1 : i == 3 ? K_NORMT : i == 4 ? K_DFTT : i == 5 ? K_DFTC :
         i == 6 ? K_OUTC : i == 7 ? K_NORM2 : i == 8 ? K_GU2 : K_DOWN2;
}
__device__ __forceinline__ void run_phase(int ph, int rep, const Params& p, char* smem) {
  int kind, l;
  if (ph == 0) { kind = K_PREP; l = 0; }
  else if (ph <= 11) { l = 0; kind = ph; }
  else {
    l = 1;
    const int i = ph - 12;
    kind = i == 0 ? K_NORM0 : i == 1 ? K_GU1 : i == 2 ? K_DOWN1 : i == 3 ? K_NORMT : i == 4 ? K_DFTT : i == 5 ? K_DFTC :
           i == 6 ? K_OUTC : i == 7 ? K_NORM2 : i == 8 ? K_GU2 : K_DOWN2;
  }
  switch (kind) {
    case K_PREP: ph_prep(p, smem); break;
    case K_NORM0: case K_NORM1: case K_NORM2: case K_NORMT: ph_norm(p, l, kind, smem); break;
    case K_GU1: ph_gu(p, l, 0, smem); break;
    case K_GU2: ph_gu(p, l, 1, smem); break;
    case K_DOWN1: case K_DOWN2: case K_OUTAB: case K_OUTC: ph_resid(p, l, kind, rep, smem); break;
    case K_INPROJ: ph_inproj(p, smem); break;
    case K_ATTLRU: ph_attn(p, smem); ph_lru1(p, smem); break;
    case K_LRU2: ph_lru2(p); break;
    case K_DFTT: ph_dftt(p, smem); break;
    case K_DFTC: ph_dftc(p, smem); break;
  }
}

__global__ void __launch_bounds__(256, 2) mega(Params p_) {
  __shared__ __attribute__((aligned(16))) char smem[SMEM_BYTES + 16];
  cg::grid_group grid = cg::this_grid();
  const int ph_lo = p_.ph_lo, ph_hi = p_.ph_hi, coop = p_.coop;
  volatile LAS unsigned* st = (volatile LAS unsigned*)(smem + SMEM_BYTES);
  if (threadIdx.x == 0) { st[0] = 0u; st[1] = 0u; st[2] = 0u; st[3] = 0u; }
  __syncthreads();
  XcdBarrier xb = xcd_barrier_post((unsigned*)(p_.ws + WS_BAR), st);
  for (int ph = ph_lo; ph < ph_hi; ++ph) {
    auto ka = __builtin_amdgcn_kernarg_segment_ptr();
    asm volatile("" : "+s"(ka));
    const Params& p = *(const Params*)ka;
    const int nrep = ((REPMASK >> kind_of(ph)) & 1u) ? 1 + REPN : 1;
    for (int rep = nrep - 1; rep >= 0; --rep) {
      run_phase(ph, rep, p, smem);
      if (ph + 1 < ph_hi || rep > 0) {
        const bool need_acq = (ph == 8 || ph == 11 || ph == 14 || ph == 18) || rep > 0;
        if (coop == 1) xcd_barrier(xb, need_acq);
        else if (coop == 2) grid.sync();
      }
    }
  }
}

extern "C" void kernel_launch(void* const* d_in, const int* in_sizes, int n_in, void* d_out, int out_size, void* d_ws,
                              size_t ws_size, hipStream_t stream) {
  static int grid_blocks = 0;
  if (!grid_blocks) {
    int dev = 0, cus = 0, per_cu = 0;
    hipGetDevice(&dev);
    hipDeviceGetAttribute(&cus, hipDeviceAttributeMultiprocessorCount, dev);
    hipOccupancyMaxActiveBlocksPerMultiprocessor(&per_cu, mega, 256, 0);
    if (per_cu > 2) per_cu = 2;
    if (per_cu < 1) per_cu = 1;
    grid_blocks = cus * per_cu;
    if (ws_size < WS_END) fprintf(stderr, "workspace too small: %zu < %zu\n", ws_size, (size_t)WS_END);
  }
  Params p{};
  for (int i = 0; i < 30; ++i) p.in[i] = (const float*)d_in[i];
  p.out = (float*)d_out;
  p.ws = (char*)d_ws;
#if ONE_LAUNCH
  p.ph_lo = 0; p.ph_hi = NPH; p.coop = 1;
  hipMemsetAsync((char*)d_ws + WS_BAR, 0, XCD_BAR_WORDS * 4, stream);
  void* args[] = {&p};
  hipError_t e = hipLaunchCooperativeKernel((void*)mega, dim3(grid_blocks), dim3(256), args, 0, stream);
  if (e != hipSuccess) fprintf(stderr, "cooperative launch failed: %s (grid %d)\n", hipGetErrorString(e), grid_blocks);
#else
  for (int ph = 0; ph < NPH; ++ph) {
    p.ph_lo = ph; p.ph_hi = ph + 1; p.coop = 0;
    hipLaunchKernelGGL(mega, dim3(grid_blocks), dim3(256), 0, stream, p);
  }
#endif
}
```
